# Optimizing an MI355X kernel written in HIP

```python
import math
import jax
import jax.numpy as jnp
from jax import lax
import numpy as np

D_MODEL = 2048
BATCH = 16
SEQ = 2048
DEPTH = 4

GRID_W = 64
CTX_LEN = 256
N_BRANCH = 4
W_BR = D_MODEL // N_BRANCH
CHUNK = 128
A_GROUPS = 4
A_GROUP_DIM = W_BR // A_GROUPS
B_GROUPS = 4
B_GROUP_DIM = W_BR // B_GROUPS
C_HEADS = 4
C_HEAD_DIM = W_BR // C_HEADS
WIN_H = 8
WIN_W = 16
S5_GROUP_CH = 16
S5_GROUPS = W_BR // S5_GROUP_CH
S5_STATE = 64
OFF_D_U = 0
OFF_C_K = OFF_D_U + W_BR
OFF_C_V = OFF_C_K + W_BR
OFF_C_Q = OFF_C_V + W_BR
OFF_A_UV = OFF_C_Q + W_BR
OFF_B = OFF_A_UV + 2 * W_BR
OFF_GATE = OFF_B + W_BR
OFF_MERGE = OFF_GATE + N_BRANCH * W_BR
IN_COLS = OFF_MERGE + N_BRANCH * D_MODEL
CTX_SIDE_COLS = OFF_C_Q

DEEPNORM_ALPHA = (2 * DEPTH) ** 0.25
DEEPNORM_BETA = (8 * DEPTH) ** -0.25
LN_EPS = 1e-6
NEG_INF = -1e30

kernel_name = 'hybrid_parallel_mixer_flow_backbone'


def _ln(x):
    xf = x.astype(jnp.float32)
    mu = jnp.mean(xf, axis=-1, keepdims=True)
    var = jnp.mean(jnp.square(xf - mu), axis=-1, keepdims=True)
    return ((xf - mu) * lax.rsqrt(var + LN_EPS)).astype(x.dtype)


def _cols(z, off, width):
    return z[..., off:off + width]


def _chunk_sgu(uv, w_s, b_s):
    bsz, n, _ = uv.shape
    u, v = jnp.split(jax.nn.gelu(uv), 2, axis=-1)
    v = _ln(v).reshape(bsz, n // CHUNK, CHUNK, A_GROUPS, A_GROUP_DIM)
    v = jnp.einsum('gpq,bkqgc->bkpgc', w_s, v) + b_s.T[:, :, None]
    return u * v.reshape(bsz, n, W_BR)


def _fourier_mix(z, w_f, b_f):
    bsz, n, _ = z.shape
    zg = z.astype(jnp.float32).reshape(bsz, n, B_GROUPS, B_GROUP_DIM)
    f = jnp.fft.fftn(zg, axes=(1, 3), norm='ortho').real.astype(z.dtype)
    return jnp.einsum('bngc,gcd->bngd', f, w_f).reshape(bsz, n, W_BR) + b_f


def _neighbourhood_attention(q, k, v, ck, cv, rpb):
    bsz, n, _ = q.shape
    rows = n // GRID_W
    kh = min(WIN_H, rows)
    kw = min(WIN_W, GRID_W)
    scale = C_HEAD_DIM ** -0.5
    q = q.reshape(bsz, rows, GRID_W, C_HEADS, C_HEAD_DIM)
    k = k.reshape(bsz, rows, GRID_W, C_HEADS, C_HEAD_DIM)
    v = v.reshape(bsz, rows, GRID_W, C_HEADS, C_HEAD_DIM)
    ck = ck.reshape(bsz, -1, C_HEADS, C_HEAD_DIM)
    cv = cv.reshape(bsz, -1, C_HEADS, C_HEAD_DIM)
    r = jnp.arange(rows)
    w = jnp.arange(GRID_W)
    row_start = jnp.clip(r - kh // 2, 0, rows - kh)
    row_idx = row_start[:, None] + jnp.arange(kh)[None, :]
    k_band = k[:, row_idx]
    v_band = v[:, row_idx]
    col_start = jnp.clip(w - kw // 2, 0, GRID_W - kw)
    in_win = (w[None, :] >= col_start[:, None]) & (w[None, :] < col_start[:, None] + kw)
    dr = row_idx - r[:, None]
    dc = jnp.clip(w[None, :] - w[:, None], -(kw - 1), kw - 1)
    bias = rpb.astype(jnp.float32)[:, dr + WIN_H - 1][..., dc + WIN_W - 1]
    bias = jnp.where(in_win[None, None, :, None, :], bias.transpose(0, 1, 3, 2, 4), NEG_INF)
    s_band = jnp.einsum('brqhd,brikhd->bhrqik', q, k_band).astype(jnp.float32) * scale + bias[None]
    s_ctx = jnp.einsum('brqhd,blhd->bhrql', q, ck).astype(jnp.float32) * scale
    n_band = kh * GRID_W
    s_all = jnp.concatenate([s_band.reshape(s_band.shape[:4] + (n_band,)), s_ctx], axis=-1)
    p = jax.nn.softmax(s_all, axis=-1).astype(v.dtype)
    p_band = p[..., :n_band].reshape(s_band.shape)
    p_ctx = p[..., n_band:]
    out = jnp.einsum('bhrqik,brikhd->brqhd', p_band, v_band) + jnp.einsum('bhrql,blhd->brqhd', p_ctx, cv)
    return out.reshape(bsz, n, W_BR)


def _context_attention(cq, ck, cv):
    bsz, lc, _ = cq.shape
    cq = cq.reshape(bsz, lc, C_HEADS, C_HEAD_DIM)
    ck = ck.reshape(bsz, lc, C_HEADS, C_HEAD_DIM)
    cv = cv.reshape(bsz, lc, C_HEADS, C_HEAD_DIM)
    s = jnp.einsum('blhd,bmhd->bhlm', cq, ck).astype(jnp.float32) * (C_HEAD_DIM ** -0.5)
    p = jax.nn.softmax(s, axis=-1).astype(cv.dtype)
    return jnp.einsum('bhlm,bmhd->blhd', p, cv).reshape(bsz, lc, W_BR)


def _cmul(ar, ai, br, bi):
    return ar * br - ai * bi, ar * bi + ai * br


def _scan_combine(e1, e2):
    a1r, a1i, b1r, b1i = e1
    a2r, a2i, b2r, b2i = e2
    ar, ai = _cmul(a1r, a1i, a2r, a2i)
    br, bi = _cmul(a2r, a2i, b1r, b1i)
    return ar, ai, br + b2r, bi + b2i


def _s5_scan(u, a_re, a_im, log_dt, b_re, b_im, reverse, h0=None):
    dt = jnp.exp(log_dt)[:, None]
    lr, li = a_re * dt, a_im * dt
    mag = jnp.exp(lr)
    abar_re, abar_im = mag * jnp.cos(li), mag * jnp.sin(li)
    den = a_re * a_re + a_im * a_im
    f_re = ((abar_re - 1.0) * a_re + abar_im * a_im) / den
    f_im = (abar_im * a_re - (abar_re - 1.0) * a_im) / den
    bb_re = f_re[..., None] * b_re - f_im[..., None] * b_im
    bb_im = f_re[..., None] * b_im + f_im[..., None] * b_re
    bu_re = jnp.einsum('bngh,gph->bngp', u, bb_re)
    bu_im = jnp.einsum('bngh,gph->bngp', u, bb_im)
    n = u.shape[1]
    a_seq_re = jnp.broadcast_to(abar_re, (1, n) + abar_re.shape)
    a_seq_im = jnp.broadcast_to(abar_im, (1, n) + abar_im.shape)
    _, _, x_re, x_im = lax.associative_scan(_scan_combine, (a_seq_re, a_seq_im, bu_re, bu_im), axis=1, reverse=reverse)
    if h0 is not None:
        steps = jnp.arange(n, 0, -1) if reverse else jnp.arange(1, n + 1)
        steps = steps.astype(jnp.float32)[:, None, None]
        pm = jnp.exp(steps * lr)
        p_re, p_im = pm * jnp.cos(steps * li), pm * jnp.sin(steps * li)
        h_re, h_im = h0[0][:, None], h0[1][:, None]
        x_re = x_re + p_re * h_re - p_im * h_im
        x_im = x_im + p_re * h_im + p_im * h_re
    return x_re, x_im


def _s5_readout(xs, c_re, c_im):
    return jnp.einsum('bngp,ghp->bngh', xs[0], c_re) - jnp.einsum('bngp,ghp->bngh', xs[1], c_im)


def _s5_branch(ux, uc, a_re, a_im, log_dt, b_re, b_im, c_re, c_im, d, w_glu, b_glu, need_ctx):
    dtype = ux.dtype
    f32 = jnp.float32
    a_re, a_im, log_dt = a_re.astype(f32), a_im.astype(f32), log_dt.astype(f32)
    b_re, b_im, c_re, c_im = b_re.astype(f32), b_im.astype(f32), c_re.astype(f32), c_im.astype(f32)
    bsz, n, _ = ux.shape
    ux_g = ux.astype(f32).reshape(bsz, n, S5_GROUPS, S5_GROUP_CH)
    uc_g = uc.astype(f32).reshape(bsz, uc.shape[1], S5_GROUPS, S5_GROUP_CH)
    fwd = (a_re[0], a_im[0], log_dt[0], b_re[0], b_im[0])
    bwd = (a_re[1], a_im[1], log_dt[1], b_re[1], b_im[1])
    xcf = _s5_scan(uc_g, *fwd, reverse=False)
    xcb = _s5_scan(uc_g, *bwd, reverse=True)
    xf = _s5_scan(ux_g, *fwd, reverse=False, h0=(xcf[0][:, -1], xcf[1][:, -1]))
    xb = _s5_scan(ux_g, *bwd, reverse=True, h0=(xcb[0][:, 0], xcb[1][:, 0]))

    def emit(u_g, sf, sb):
        y = _s5_readout(sf, c_re[0], c_im[0]) + _s5_readout(sb, c_re[1], c_im[1])
        y = y.reshape(bsz, -1, W_BR) + d.astype(f32) * u_g.reshape(bsz, -1, W_BR)
        y = jax.nn.gelu(y).astype(dtype)
        return y * jax.nn.sigmoid(y @ w_glu + b_glu)

    y_ctx = emit(uc_g, xcf, xcb) if need_ctx else None
    return emit(ux_g, xf, xb), y_ctx


def _merge_residual(x, z, ys, gate, w_up, w_o, ln_g, ln_b):
    m = None
    for i, y in enumerate(ys):
        y = y * jax.nn.silu(_cols(z, OFF_GATE + i * W_BR, W_BR))
        term = jax.nn.sigmoid(_cols(z, OFF_MERGE + i * D_MODEL, D_MODEL)) * (y @ w_up[i])
        m = term if m is None else m + term
    out = m @ w_o
    return _ln(DEEPNORM_ALPHA * x + gate * out) * ln_g + ln_b


def setup_inputs(seed: int = 0) -> dict:
    key = jax.random.key(seed)
    ks = jax.random.split(key, 28)
    f32 = jnp.float32
    L, G, P, H = DEPTH, S5_GROUPS, S5_STATE, S5_GROUP_CH

    def nrm(k, shape, s):
        return jax.random.normal(k, shape, f32) * s

    n_idx = jnp.arange(P, dtype=f32)
    return {
        'x': nrm(ks[0], (BATCH, SEQ, D_MODEL), 1.0),
        'c': nrm(ks[1], (BATCH, D_MODEL), 1.0),
        'ctx': nrm(ks[2], (BATCH, CTX_LEN, D_MODEL), 1.0),
        'c_ctx': nrm(ks[3], (D_MODEL,), 1.0),
        'w_ada': nrm(ks[4], (L, D_MODEL, 3 * D_MODEL), D_MODEL ** -0.5),
        'b_ada': nrm(ks[5], (L, 3 * D_MODEL), 0.02),
        'w_in': nrm(ks[6], (L, D_MODEL, IN_COLS), D_MODEL ** -0.5),
        'b_in': nrm(ks[7], (L, IN_COLS), 0.02),
        'w_sgu': nrm(ks[8], (L, A_GROUPS, CHUNK, CHUNK), CHUNK ** -0.5),
        'b_sgu': 1.0 + nrm(ks[9], (L, A_GROUPS, CHUNK), 0.1),
        'w_fnet': nrm(ks[10], (L, B_GROUPS, B_GROUP_DIM, B_GROUP_DIM), B_GROUP_DIM ** -0.5),
        'b_fnet': nrm(ks[11], (L, W_BR), 0.02),
        'rpb': nrm(ks[12], (L, C_HEADS, 2 * WIN_H - 1, 2 * WIN_W - 1), 0.1),
        's5_a_re': -0.5 + nrm(ks[13], (L, 2, G, P), 0.01),
        's5_a_im': math.pi * n_idx + nrm(ks[14], (L, 2, G, P), 0.01),
        's5_log_dt': jax.random.uniform(ks[15], (L, 2, G), f32, math.log(1e-3), math.log(1e-1)),
        's5_b_re': nrm(ks[16], (L, 2, G, P, H), (2 * H) ** -0.5),
        's5_b_im': nrm(ks[17], (L, 2, G, P, H), (2 * H) ** -0.5),
        's5_c_re': nrm(ks[18], (L, 2, G, H, P), P ** -0.5),
        's5_c_im': nrm(ks[19], (L, 2, G, H, P), P ** -0.5),
        's5_d': nrm(ks[20], (L, W_BR), 1.0),
        's5_w_glu': nrm(ks[21], (L, W_BR, W_BR), W_BR ** -0.5),
        's5_b_glu': nrm(ks[22], (L, W_BR), 0.02),
        'w_up': nrm(ks[23], (L, N_BRANCH, W_BR, D_MODEL), DEEPNORM_BETA * W_BR ** -0.5),
        'w_o': nrm(ks[24], (L, D_MODEL, D_MODEL), DEEPNORM_BETA * D_MODEL ** -0.5),
        'ln_g': 1.0 + nrm(ks[25], (L, D_MODEL), 0.02),
        'ln_b': nrm(ks[26], (L, D_MODEL), 0.02),
    }


def reference(x, c, ctx, c_ctx, w_ada, b_ada, w_in, b_in, w_sgu, b_sgu, w_fnet, b_fnet, rpb,
              s5_a_re, s5_a_im, s5_log_dt, s5_b_re, s5_b_im, s5_c_re, s5_c_im, s5_d, s5_w_glu, s5_b_glu,
              w_up, w_o, ln_g, ln_b):
    silu_c = jax.nn.silu(c)
    silu_cc = jax.nn.silu(c_ctx)
    for l in range(DEPTH):
        need_ctx = l < DEPTH - 1
        ada_x = silu_c @ w_ada[l] + b_ada[l]
        ada_c = silu_cc @ w_ada[l] + b_ada[l]
        shift_x, scale_x, gate_x = jnp.split(ada_x[:, None, :], 3, axis=-1)
        shift_c, scale_c, gate_c = jnp.split(ada_c, 3, axis=-1)
        hx = _ln(x) * (1.0 + scale_x) + shift_x
        hc = _ln(ctx) * (1.0 + scale_c) + shift_c
        cols = IN_COLS if need_ctx else CTX_SIDE_COLS
        zx = hx @ w_in[l] + b_in[l]
        zc = hc @ w_in[l][:, :cols] + b_in[l][:cols]

        yd_x, yd_c = _s5_branch(_cols(zx, OFF_D_U, W_BR), _cols(zc, OFF_D_U, W_BR),
                                s5_a_re[l], s5_a_im[l], s5_log_dt[l], s5_b_re[l], s5_b_im[l],
                                s5_c_re[l], s5_c_im[l], s5_d[l], s5_w_glu[l], s5_b_glu[l], need_ctx)
        ck, cv = _cols(zc, OFF_C_K, W_BR), _cols(zc, OFF_C_V, W_BR)
        yc_x = _neighbourhood_attention(_cols(zx, OFF_C_Q, W_BR), _cols(zx, OFF_C_K, W_BR),
                                        _cols(zx, OFF_C_V, W_BR), ck, cv, rpb[l])
        ya_x = _chunk_sgu(_cols(zx, OFF_A_UV, 2 * W_BR), w_sgu[l], b_sgu[l])
        yb_x = _fourier_mix(_cols(zx, OFF_B, W_BR), w_fnet[l], b_fnet[l])
        x_new = _merge_residual(x, zx, (ya_x, yb_x, yc_x, yd_x), gate_x, w_up[l], w_o[l], ln_g[l], ln_b[l])
        if need_ctx:
            yc_c = _context_attention(_cols(zc, OFF_C_Q, W_BR), ck, cv)
            ya_c = _chunk_sgu(_cols(zc, OFF_A_UV, 2 * W_BR), w_sgu[l], b_sgu[l])
            yb_c = _fourier_mix(_cols(zc, OFF_B, W_BR), w_fnet[l], b_fnet[l])
            ctx = _merge_residual(ctx, zc, (ya_c, yb_c, yc_c, yd_c), gate_c, w_up[l], w_o[l], ln_g[l], ln_b[l])
        x = x_new
    return x
```

```cpp
#include <hip/hip_runtime.h>
#include <cstdio>
#include <cstdint>

#ifndef MK_MULTI
#define MK_MULTI 0
#endif

#define LAS __attribute__((address_space(3)))
#define GAS __attribute__((address_space(1)))
typedef unsigned short bf16_t;
typedef short bf16x8 __attribute__((ext_vector_type(8)));
typedef short s16x4 __attribute__((ext_vector_type(4)));
typedef float f32x4 __attribute__((ext_vector_type(4)));
typedef float f32x2 __attribute__((ext_vector_type(2)));
typedef float f32x16 __attribute__((ext_vector_type(16)));
typedef unsigned u32x4 __attribute__((ext_vector_type(4)));
typedef unsigned u32x2 __attribute__((ext_vector_type(2)));
typedef __bf16 bf16x2_t __attribute__((ext_vector_type(2)));

constexpr int DM = 2048, NBATCH = 16, SEQ = 2048, CTXL = 256, DEPTH = 4;
constexpr int MX = NBATCH * SEQ, MC = NBATCH * CTXL, MT = MX + MC;
constexpr int WBR = 512, IN_COLS = 13824;
constexpr int OFF_D_U = 0, OFF_C_K = 512, OFF_C_V = 1024, OFF_C_Q = 1536, OFF_A_UV = 2048, OFF_B = 3072, OFF_GATE = 3584, OFF_MERGE = 5632;
constexpr int N1A = 12800, N1B = 1024, LDZ = 4096;
constexpr int ZC_B = 0, ZC_K = 512, ZC_Q = 1024, ZC_AU = 1536, ZC_GATE = 2048, ZC_MERGE = 4096;
constexpr int XS_ROWS = 1280, XS_K = 768;
constexpr float LN_EPS = 1e-6f;
constexpr float DN_ALPHA = 1.681792830507429f;

constexpr size_t MiB = 1u << 20;
constexpr size_t WS_CTL = 0, CTL_ZERO_BYTES = 1 * MiB;
constexpr size_t WS_ADA = 1 * MiB;
constexpr size_t WS_BIAS1A = 3 * MiB;
constexpr size_t WS_BIAS1B = 3 * MiB + 65536;
constexpr size_t WS_AT = 3 * MiB + 131072;
constexpr size_t AT_STRIDE = 32768;
constexpr size_t WS_WSGU = 3 * MiB + 262144;
constexpr size_t WS_DFT256 = 4 * MiB;
constexpr size_t WS_WFT = 5 * MiB;
constexpr size_t WS_DFT = 6 * MiB;
constexpr size_t WS_WIN = 22 * MiB;
constexpr size_t WS_WSW = 72 * MiB;
constexpr size_t WS_WUP = 76 * MiB, WUP_STRIDE = 8 * MiB;
constexpr size_t WS_WO = 92 * MiB, WO_STRIDE = 8 * MiB;
constexpr size_t WS_WGLU = 108 * MiB, WGLU_STRIDE = 512 * 1024;
constexpr size_t WS_MEND = 109 * MiB;
constexpr size_t WS_W3 = 117 * MiB, W3_STRIDE = 24 * MiB;
constexpr size_t WS_XS = 165 * MiB;
constexpr size_t WS_E = 225 * MiB;
constexpr size_t WS_YD = 265 * MiB;
constexpr size_t WS_H = 301 * MiB;
constexpr size_t WS_Y = 445 * MiB;
constexpr size_t WS_SW = 589 * MiB;
constexpr size_t WS_VT = WS_SW, WS_PTX = WS_SW + 36 * MiB, WS_PTC = WS_SW + 100 * MiB, WS_VTS = WS_SW + 108 * MiB;
constexpr size_t WS_CTXR = 733 * MiB;
constexpr size_t WS_Z = 765 * MiB;
constexpr size_t WS_ZM = 1053 * MiB;
constexpr size_t WS_ADAP = WS_Z;
constexpr size_t WS_RS = 1629 * MiB;
constexpr size_t WS_WIN2 = 1630 * MiB, WS_WSW2 = 1680 * MiB, WS_WFT2 = 1684 * MiB, WS_MEND2 = 1685 * MiB;
constexpr size_t SMALL_STRIDE = 512 * 1024;
constexpr size_t WS_END = 1693 * MiB;

constexpr int RING_BYTES = 131072;
constexpr int LDS_BYTES = 148480;
constexpr int MISC_OFF = 147456;

__device__ __forceinline__ unsigned pk2(float lo, float hi) { f32x2 v = {lo, hi}; bf16x2_t b = __builtin_convertvector(v, bf16x2_t); return __builtin_bit_cast(unsigned, b); }
__device__ __forceinline__ float bflo(unsigned w) { return __uint_as_float(w << 16); }
__device__ __forceinline__ float bfhi(unsigned w) { return __uint_as_float(w & 0xffff0000u); }
__device__ __forceinline__ float bf1(bf16_t b) { return __uint_as_float(((unsigned)b) << 16); }
__device__ __forceinline__ float sigm(float x) { return __builtin_amdgcn_rcpf(1.0f + __builtin_amdgcn_exp2f(-1.4426950408889634f * x)); }
__device__ __forceinline__ float silu_f(float x) { return x * sigm(x); }
__device__ __forceinline__ float gelu_t(float x) { return x * sigm(1.5957691216057308f * (x + 0.044715f * x * x * x)); }
__device__ __forceinline__ float shx(float v, int o, int lane) { return __builtin_bit_cast(float, __builtin_amdgcn_ds_bpermute((lane ^ o) << 2, __builtin_bit_cast(int, v))); }
__device__ __forceinline__ float wave_sum(float v, int lane) {
    (void)lane;
#define WS_DPP(ctrl) v += __builtin_bit_cast(float, __builtin_amdgcn_update_dpp(0, __builtin_bit_cast(int, v), ctrl, 0xF, 0xF, true))
    WS_DPP(0xB1); WS_DPP(0x4E); WS_DPP(0x141); WS_DPP(0x140);
#undef WS_DPP
    v += __builtin_bit_cast(float, __builtin_amdgcn_ds_swizzle(__builtin_bit_cast(int, v), 0x401F));
    float a = v, b = v;
    asm volatile("s_nop 1\n\tv_permlane32_swap_b32 %0, %1" : "+v"(a), "+v"(b));
    return a + b;
}
#define LDS_WAIT() asm volatile("s_waitcnt lgkmcnt(0)" ::: "memory")
#define VM_WAIT() asm volatile("s_waitcnt vmcnt(0)" ::: "memory")

namespace pg8 {
constexpr int BM = 256, BK = 64, HALF = 128, HTB = HALF * BK * 2, STAGE_BYTES = 8 * HTB, NXCD = 8, WGM = 4;
__host__ __device__ __forceinline__ int lds_byte(int r, int c) { const int st = (r >> 4) * 2 + (c >> 5), rr = r & 15, cc = c & 31, ob = rr * 64 + cc * 2; return st * 1024 + (ob ^ (((ob >> 9) & 1) << 5)); }
__host__ __device__ __forceinline__ void stage_rc(int b, int& R, int& C) { const int st = b / 1024, sb = b % 1024, swz = sb ^ (((sb >> 9) & 1) << 5); R = (st >> 1) * 16 + swz / 64; C = (st & 1) * 32 + (swz % 64) / 2; }
__host__ __device__ __forceinline__ int perm32(int rho) { const int n = rho >> 4, i = rho & 15; return 8 * (i >> 2) + 4 * n + (i & 3); }

struct Unit { int pm, pn, z; };
__device__ __forceinline__ const char* uni(const char* p) {
    const unsigned long long v = (unsigned long long)p;
    const unsigned lo = __builtin_amdgcn_readfirstlane((unsigned)v), hi = __builtin_amdgcn_readfirstlane((unsigned)(v >> 32));
    return (const char*)(((unsigned long long)hi << 32) | lo);
}
struct Gemm { const bf16_t* A; const bf16_t* Bt; int lda, ldb, K; size_t zA, zB; };

struct TileOrder {
    int nM, nN, nwg, G, c, pm0, pn0;
    __device__ void init(int nM_, int nN_, int G_, int c_, int pm0_ = 0, int pn0_ = 0) { nM = nM_; nN = nN_; nwg = nM * nN; G = G_; c = c_; pm0 = pm0_; pn0 = pn0_; }
    __device__ bool tile(int i, int& pm, int& pn) const { const long L = (long)i * G + c; if (L >= nwg) return false; tile_of((int)L, pm, pn); return true; }
    __device__ void tile_of(int L, int& pm, int& pn) const {
        int wgid = L; { const int q = nwg / NXCD, r = nwg % NXCD, xcd = wgid % NXCD, off = wgid / NXCD; wgid = (xcd < r ? xcd * (q + 1) : r * (q + 1) + (xcd - r) * q) + off; }
        const int nig = WGM * nN, gid = wgid / nig, fm = gid * WGM, gsz = (nM - fm) < WGM ? (nM - fm) : WGM;
        pm = pm0 + fm + ((wgid % nig) % gsz); pn = pn0 + (wgid % nig) / gsz;
    }
};
struct G1Order {
    int G, c; bool lastl;
    __device__ bool next(int i, Unit& u) const {
        int L = i * G + c; TileOrder t; const int mrows = lastl ? 128 : 144;
        const int n0 = mrows * 50; if (L < n0) { t.init(mrows, 50, G, 0); t.tile_of(L, u.pm, u.pn); u.z = 0; return true; } L -= n0;
        if (lastl) { if (L < 64) { t.init(16, 4, G, 0, 128, 0); t.tile_of(L, u.pm, u.pn); u.z = 0; return true; } L -= 64; }
        const int n2 = 4 * mrows; if (L < n2) { t.init(4, mrows, G, 0); t.tile_of(L, u.pm, u.pn); u.z = 1; return true; } L -= n2;
        if (lastl && L < 32) { t.init(2, 16, G, 0, 0, 128); t.tile_of(L, u.pm, u.pn); u.z = 1; return true; }
        return false;
    }
};
struct HeadOrder : TileOrder {
    int lim;
    __device__ bool next(int i, Unit& u) const { const int L = i * G + c; if (L >= lim) return false; u.z = 0; tile_of(L, u.pm, u.pn); return true; }
};
struct TailOrder : TileOrder {
    int lim;
    __device__ bool next(int i, Unit& u) const { if (i > 0) return false; const int L = lim + (c >> 1); if (L >= nwg) return false; u.z = 0; tile_of(L, u.pm, u.pn); u.pn = 2 * u.pn + (c & 1); return true; }
};
struct StaticOrder : TileOrder {
    __device__ bool next(int i, Unit& u) const { u.z = 0; return tile(i, u.pm, u.pn); }
};
struct QuadOrder : TileOrder {
    __device__ bool next(int i, Unit& u) const { u.z = i & 3; return tile(i >> 2, u.pm, u.pn); }
};
struct BatchOrder {
    int nM, nN, nZ, G, c;
    __device__ void init(int nM_, int nN_, int nZ_, int G_, int c_) { nM = nM_; nN = nN_; nZ = nZ_; G = G_; c = c_; }
    __device__ bool next(int i, Unit& u) const {
        const int L = i * G + c; if (L >= nM * nN * nZ) return false;
        u.z = L / (nM * nN); const int r = L % (nM * nN); u.pm = r / nN; u.pn = r % nN; return true;
    }
};

template <class E, class = void> struct HasAhead { static constexpr bool value = false; };
template <class E> struct HasAhead<E, decltype((void)E::AHEAD)> { static constexpr bool value = true; };
template <class E, class = void> struct HasPre { static constexpr bool value = false; };
template <class E> struct HasPre<E, decltype((void)E::HAS_PRE)> { static constexpr bool value = true; };
template <class Epi, class Sched, bool ALIGN_EPI = true>
__device__ __forceinline__ void gemm_phase(LAS unsigned char* lds, const Gemm g, const Sched& S, Epi& E, int tid) {
    asm volatile("" : "+v"(tid));
    const int wid = __builtin_amdgcn_readfirstlane(tid >> 6), lane = tid & 63, wr = wid >> 2, wc = wid & 3, fr = lane & 15, fq = lane >> 4;
    const int K = g.K, nt = K / BK;
    unsigned voffA[2], voffB[2];
#pragma unroll
    for (int i = 0; i < 2; ++i) { int R, C; stage_rc(tid * 16 + i * 8192, R, C); const int Rb = Epi::PERM ? ((R & ~31) + perm32(R & 31)) : R;
        voffA[i] = (unsigned)(R * g.lda + C) * 2u; voffB[i] = (unsigned)(Rb * g.ldb + C) * 2u; }
    const size_t kstep = (size_t)(BK * 2);
    const size_t hstepA = (size_t)HALF * g.lda * 2, hstepB = (size_t)HALF * g.ldb * 2;
    const size_t tstepA = 2 * hstepA, tstepB = 2 * hstepB;
    const unsigned ldsw = (unsigned)wid * 1024u;
    const int aoff = lds_byte(wr * 64 + fr, fq * 8), boff = lds_byte(wc * 32 + fr, fq * 8);
#define PG8_SA(b, h) (((b) * 2 + (h)) * HTB)
#define PG8_SB(b, h) ((4 + (b) * 2 + (h)) * HTB)
#define PG8_STAGE(bufoff, gbase, voff) do { _Pragma("unroll") for (int _i = 0; _i < 2; ++_i) \
        __builtin_amdgcn_global_load_lds((const unsigned*)((const char*)(gbase) + (voff)[_i]), (LAS unsigned*)(lds + (bufoff) + ldsw + _i * 8192), 16, 0, 0); } while (0)
#define PG8_LDA(dst, b, h) do { _Pragma("unroll") for (int m = 0; m < 4; ++m) _Pragma("unroll") for (int k = 0; k < 2; ++k) dst[m][k] = *(const LAS bf16x8*)(lds + PG8_SA(b, h) + aoff + m * 2048 + k * 1024); } while (0)
#define PG8_LDB(dst, b, h) do { _Pragma("unroll") for (int n = 0; n < 2; ++n) _Pragma("unroll") for (int k = 0; k < 2; ++k) dst[n][k] = *(const LAS bf16x8*)(lds + PG8_SB(b, h) + boff + n * 2048 + k * 1024); } while (0)
#define PG8_MMA(ai, bj, At, Bt) do { __builtin_amdgcn_s_setprio(1); _Pragma("unroll") for (int m = 0; m < 4; ++m) _Pragma("unroll") for (int n = 0; n < 2; ++n) _Pragma("unroll") for (int k = 0; k < 2; ++k) \
        acc[ai][bj][m][n] = __builtin_amdgcn_mfma_f32_16x16x32_bf16(Bt[n][k], At[m][k], acc[ai][bj][m][n], 0, 0, 0); __builtin_amdgcn_s_setprio(0); } while (0)
#define PG8_WAIT_V(n) asm volatile("s_waitcnt vmcnt(" #n ")" ::: "memory")
#define PG8_WAIT_L(n) asm volatile("s_waitcnt lgkmcnt(" #n ")" ::: "memory")
#define PG8_BAR __builtin_amdgcn_s_barrier()
#define PG8_SCHED __builtin_amdgcn_sched_barrier(0)
    Unit cur, nxt; int ui = 0;
    if (!S.next(0, cur)) return;
    f32x4 acc[2][2][4][2];
#pragma unroll
    for (int a = 0; a < 2; ++a)
#pragma unroll
        for (int b = 0; b < 2; ++b)
#pragma unroll
            for (int m = 0; m < 4; ++m)
#pragma unroll
                for (int n = 0; n < 2; ++n) acc[a][b][m][n] = (f32x4){0.f, 0.f, 0.f, 0.f};
    bf16x8 At[4][2], B0[2][2], B1[2][2];
    const char* cA = (const char*)g.A + (size_t)cur.pm * tstepA + (size_t)cur.z * g.zA; const char* cB = (const char*)g.Bt + (size_t)cur.pn * tstepB + (size_t)cur.z * g.zB;
    PG8_STAGE(PG8_SB(0, 0), cB, voffB); PG8_STAGE(PG8_SB(0, 1), cB + hstepB, voffB); PG8_STAGE(PG8_SA(0, 0), cA, voffA); PG8_STAGE(PG8_SA(0, 1), cA + hstepA, voffA);
    if (wr == 1) PG8_BAR;
    PG8_WAIT_V(2); PG8_BAR;
    PG8_STAGE(PG8_SB(1, 0), cB + kstep, voffB); PG8_STAGE(PG8_SA(1, 0), cA + kstep, voffA); PG8_STAGE(PG8_SB(1, 1), cB + hstepB + kstep, voffB);
    PG8_WAIT_V(6); PG8_BAR;
    for (;;) {
        const bool has_next = S.next(ui + 1, nxt);
        const char* nA = has_next ? (const char*)g.A + (size_t)nxt.pm * tstepA + (size_t)nxt.z * g.zA : cA; const char* nB = has_next ? (const char*)g.Bt + (size_t)nxt.pn * tstepB + (size_t)nxt.z * g.zB : cB;
        if constexpr (HasPre<Epi>::value) E.pre(cur, lds, wid, lane, ui & 1);
        for (int t = 0; t < nt; t += 2) {
            const bool last = (t == nt - 2);
            const char* a1 = cA + (size_t)(t + 1) * kstep;
            const char* a2 = last ? nA : cA + (size_t)(t + 2) * kstep; const char* b2 = last ? nB : cB + (size_t)(t + 2) * kstep;
            const char* a3 = a2 + kstep; const char* b3 = b2 + kstep;
            PG8_LDB(B0, 0, 0); PG8_LDB(B1, 0, 1); PG8_SCHED; PG8_LDA(At, 0, 0); PG8_STAGE(PG8_SA(1, 1), a1 + hstepA, voffA);
            PG8_WAIT_V(8); PG8_WAIT_L(0); PG8_BAR; PG8_MMA(0, 0, At, B0); PG8_MMA(0, 1, At, B1); PG8_BAR; PG8_SCHED;
            PG8_LDA(At, 0, 1); PG8_STAGE(PG8_SB(0, 0), b2, voffB); PG8_STAGE(PG8_SB(0, 1), b2 + hstepB, voffB); PG8_STAGE(PG8_SA(0, 0), a2, voffA);
            PG8_WAIT_V(8); PG8_WAIT_L(0); PG8_BAR; PG8_MMA(1, 0, At, B0); PG8_MMA(1, 1, At, B1); PG8_BAR; PG8_SCHED;
            PG8_LDB(B0, 1, 0); PG8_LDB(B1, 1, 1); PG8_SCHED; PG8_LDA(At, 1, 0); PG8_STAGE(PG8_SA(0, 1), a2 + hstepA, voffA);
            PG8_WAIT_V(8); PG8_WAIT_L(0); PG8_BAR; PG8_MMA(0, 0, At, B0); PG8_MMA(0, 1, At, B1); PG8_BAR; PG8_SCHED;
            PG8_LDA(At, 1, 1); PG8_STAGE(PG8_SB(1, 0), b3, voffB); PG8_STAGE(PG8_SB(1, 1), b3 + hstepB, voffB); PG8_STAGE(PG8_SA(1, 0), a3, voffA);
            PG8_WAIT_V(8); PG8_WAIT_L(0); PG8_BAR; PG8_MMA(1, 0, At, B0); PG8_MMA(1, 1, At, B1); PG8_BAR; PG8_SCHED;
        }
        if constexpr (ALIGN_EPI) { if (wr == 0) PG8_BAR; }
        if constexpr (HasPre<Epi>::value) E.slot = ui & 1;
        E(acc, cur, wr, wc, fr, fq);
        if (!has_next) break;
#pragma unroll
        for (int a = 0; a < 2; ++a)
#pragma unroll
            for (int b = 0; b < 2; ++b)
#pragma unroll
                for (int m = 0; m < 4; ++m)
#pragma unroll
                    for (int n = 0; n < 2; ++n) acc[a][b][m][n] = (f32x4){0.f, 0.f, 0.f, 0.f};
        cur = nxt; cA = nA; cB = nB; ++ui;
        if constexpr (ALIGN_EPI) { if (wr == 1) PG8_BAR; }
    }
    PG8_WAIT_V(0);
    if constexpr (!ALIGN_EPI) { if (wr == 0) PG8_BAR; }
    PG8_BAR;
#undef PG8_SA
#undef PG8_SB
#undef PG8_STAGE
#undef PG8_LDA
#undef PG8_LDB
#undef PG8_MMA
#undef PG8_WAIT_V
#undef PG8_WAIT_L
#undef PG8_BAR
#undef PG8_SCHED
}

template <class Epi, class Sched, bool ALIGN_EPI = true>
__device__ __forceinline__ void gemm_phase_n128(LAS unsigned char* lds, const Gemm g, const Sched& S, Epi& E, int tid) {
    asm volatile("" : "+v"(tid));
    const int wid = __builtin_amdgcn_readfirstlane(tid >> 6), lane = tid & 63, wr = wid >> 2, wc = wid & 3, fr = lane & 15, fq = lane >> 4;
    const int K = g.K, nt = K / BK;
    unsigned voffA[2], voffB[2];
#pragma unroll
    for (int i = 0; i < 2; ++i) { int R, C; stage_rc(tid * 16 + i * 8192, R, C); const int Rb = Epi::PERM ? ((R & ~31) + perm32(R & 31)) : R;
        voffA[i] = (unsigned)(R * g.lda + C) * 2u; voffB[i] = (unsigned)(Rb * g.ldb + C) * 2u; }
    const size_t kstep = (size_t)(BK * 2);
    const size_t hstepA = (size_t)HALF * g.lda * 2, hstepB = (size_t)HALF * g.ldb * 2;
    const size_t tstepA = 2 * hstepA;
    const unsigned ldsw = (unsigned)wid * 1024u;
    const int aoff = lds_byte(wr * 64 + fr, fq * 8), boff = lds_byte(wc * 32 + fr, fq * 8);
#define PG8_SA(b, h) (((b) * 2 + (h)) * HTB)
#define PG8_SB(b, h) ((4 + (b) * 2 + (h)) * HTB)
#define PG8_STAGE(bufoff, gbase, voff) do { _Pragma("unroll") for (int _i = 0; _i < 2; ++_i) \
        __builtin_amdgcn_global_load_lds((const unsigned*)((const char*)(gbase) + (voff)[_i]), (LAS unsigned*)(lds + (bufoff) + ldsw + _i * 8192), 16, 0, 0); } while (0)
#define PG8_LDA(dst, b, h) do { _Pragma("unroll") for (int m = 0; m < 4; ++m) _Pragma("unroll") for (int k = 0; k < 2; ++k) dst[m][k] = *(const LAS bf16x8*)(lds + PG8_SA(b, h) + aoff + m * 2048 + k * 1024); } while (0)
#define PG8_LDB(dst, b, h) do { _Pragma("unroll") for (int n = 0; n < 2; ++n) _Pragma("unroll") for (int k = 0; k < 2; ++k) dst[n][k] = *(const LAS bf16x8*)(lds + PG8_SB(b, h) + boff + n * 2048 + k * 1024); } while (0)
#define PG8_MMA(ai, At, Bt) do { __builtin_amdgcn_s_setprio(1); _Pragma("unroll") for (int m = 0; m < 4; ++m) _Pragma("unroll") for (int n = 0; n < 2; ++n) _Pragma("unroll") for (int k = 0; k < 2; ++k) \
        acc[ai][m][n] = __builtin_amdgcn_mfma_f32_16x16x32_bf16(Bt[n][k], At[m][k], acc[ai][m][n], 0, 0, 0); __builtin_amdgcn_s_setprio(0); } while (0)
#define PG8_WAIT_V(n) asm volatile("s_waitcnt vmcnt(" #n ")" ::: "memory")
#define PG8_WAIT_L(n) asm volatile("s_waitcnt lgkmcnt(" #n ")" ::: "memory")
#define PG8_BAR __builtin_amdgcn_s_barrier()
#define PG8_SCHED __builtin_amdgcn_sched_barrier(0)
    Unit cur, nxt; int ui = 0;
    if (!S.next(0, cur)) return;
    f32x4 acc[2][4][2];
#pragma unroll
    for (int a = 0; a < 2; ++a)
#pragma unroll
        for (int m = 0; m < 4; ++m)
#pragma unroll
            for (int n = 0; n < 2; ++n) acc[a][m][n] = (f32x4){0.f, 0.f, 0.f, 0.f};
    bf16x8 At[4][2], B0[2][2];
    const char* cA = (const char*)g.A + (size_t)cur.pm * tstepA + (size_t)cur.z * g.zA; const char* cB = (const char*)g.Bt + (size_t)cur.pn * hstepB + (size_t)cur.z * g.zB;
    PG8_STAGE(PG8_SB(0, 0), cB, voffB); PG8_STAGE(PG8_SA(0, 0), cA, voffA); PG8_STAGE(PG8_SA(0, 1), cA + hstepA, voffA);
    if (wr == 1) PG8_BAR;
    PG8_WAIT_V(2); PG8_BAR;
    PG8_STAGE(PG8_SB(1, 0), cB + kstep, voffB); PG8_STAGE(PG8_SA(1, 0), cA + kstep, voffA);
    PG8_WAIT_V(4); PG8_BAR;
    for (;;) {
        const bool has_next = S.next(ui + 1, nxt);
        const char* nA = has_next ? (const char*)g.A + (size_t)nxt.pm * tstepA + (size_t)nxt.z * g.zA : cA; const char* nB = has_next ? (const char*)g.Bt + (size_t)nxt.pn * hstepB + (size_t)nxt.z * g.zB : cB;
        for (int t = 0; t < nt; t += 2) {
            const bool last = (t == nt - 2);
            const char* a1 = cA + (size_t)(t + 1) * kstep;
            const char* a2 = last ? nA : cA + (size_t)(t + 2) * kstep; const char* b2 = last ? nB : cB + (size_t)(t + 2) * kstep;
            const char* a3 = a2 + kstep; const char* b3 = b2 + kstep;
            PG8_LDB(B0, 0, 0); PG8_SCHED; PG8_LDA(At, 0, 0); PG8_STAGE(PG8_SA(1, 1), a1 + hstepA, voffA);
            PG8_WAIT_V(6); PG8_WAIT_L(0); PG8_BAR; PG8_MMA(0, At, B0); PG8_BAR; PG8_SCHED;
            PG8_LDA(At, 0, 1); PG8_STAGE(PG8_SB(0, 0), b2, voffB); PG8_STAGE(PG8_SA(0, 0), a2, voffA);
            PG8_WAIT_V(6); PG8_WAIT_L(0); PG8_BAR; PG8_MMA(1, At, B0); PG8_BAR; PG8_SCHED;
            PG8_LDB(B0, 1, 0); PG8_SCHED; PG8_LDA(At, 1, 0); PG8_STAGE(PG8_SA(0, 1), a2 + hstepA, voffA);
            PG8_WAIT_V(6); PG8_WAIT_L(0); PG8_BAR; PG8_MMA(0, At, B0); PG8_BAR; PG8_SCHED;
            PG8_LDA(At, 1, 1); PG8_STAGE(PG8_SB(1, 0), b3, voffB); PG8_STAGE(PG8_SA(1, 0), a3, voffA);
            PG8_WAIT_V(6); PG8_WAIT_L(0); PG8_BAR; PG8_MMA(1, At, B0); PG8_BAR; PG8_SCHED;
        }
        if constexpr (ALIGN_EPI) { if (wr == 0) PG8_BAR; }
        E(acc, cur, wr, wc, fr, fq);
        if (!has_next) break;
#pragma unroll
        for (int a = 0; a < 2; ++a)
#pragma unroll
            for (int m = 0; m < 4; ++m)
#pragma unroll
                for (int n = 0; n < 2; ++n) acc[a][m][n] = (f32x4){0.f, 0.f, 0.f, 0.f};
        cur = nxt; cA = nA; cB = nB; ++ui;
        if constexpr (ALIGN_EPI) { if (wr == 1) PG8_BAR; }
    }
    PG8_WAIT_V(0);
    if constexpr (!ALIGN_EPI) { if (wr == 0) PG8_BAR; }
    PG8_BAR;
#undef PG8_SA
#undef PG8_SB
#undef PG8_STAGE
#undef PG8_LDA
#undef PG8_LDB
#undef PG8_MMA
#undef PG8_WAIT_V
#undef PG8_WAIT_L
#undef PG8_BAR
#undef PG8_SCHED
}
constexpr int M_STG = 49152;
template <class Epi, class Sched, bool ALIGN_EPI = true>
__device__ __forceinline__ void gemm_phase_m128(LAS unsigned char* lds, const Gemm g, const Sched& S, Epi& E, int tid) {
    asm volatile("" : "+v"(tid));
    const int wid = __builtin_amdgcn_readfirstlane(tid >> 6), lane = tid & 63, wr = wid >> 2, wc = wid & 3, fr = lane & 15, fq = lane >> 4;
    const int K = g.K, nt = K / BK;
    unsigned voffA[2], voffB[2];
#pragma unroll
    for (int i = 0; i < 2; ++i) { int R, C; stage_rc(tid * 16 + i * 8192, R, C); const int Rb = Epi::PERM ? ((R & ~31) + perm32(R & 31)) : R;
        voffA[i] = (unsigned)(R * g.lda + C) * 2u; voffB[i] = (unsigned)(Rb * g.ldb + C) * 2u; }
    const size_t kstep = (size_t)(BK * 2);
    const size_t hstepA = (size_t)HALF * g.lda * 2, hstepB = (size_t)HALF * g.ldb * 2;
    const unsigned ldsw = (unsigned)wid * 1024u;
    const int aoff = lds_byte(wr * 64 + fr, fq * 8), boff = lds_byte(wc * 32 + fr, fq * 8);
#define PG8_STAGE(slot, part, gbase, voff) do { _Pragma("unroll") for (int _i = 0; _i < 2; ++_i) \
        __builtin_amdgcn_global_load_lds((const unsigned*)((const char*)(gbase) + (voff)[_i]), (LAS unsigned*)(lds + (slot) * M_STG + (part) * 16384 + ldsw + _i * 8192), 16, 0, 0); } while (0)
#define PG8_LDA(dst, so) do { _Pragma("unroll") for (int m = 0; m < 4; ++m) _Pragma("unroll") for (int k = 0; k < 2; ++k) dst[m][k] = *(const LAS bf16x8*)(lds + (so) + aoff + m * 2048 + k * 1024); } while (0)
#define PG8_LDB(dst, so, h) do { _Pragma("unroll") for (int n = 0; n < 2; ++n) _Pragma("unroll") for (int k = 0; k < 2; ++k) dst[n][k] = *(const LAS bf16x8*)(lds + (so) + 16384 * (1 + (h)) + boff + n * 2048 + k * 1024); } while (0)
#define PG8_MMA(bj, At, Bt) do { __builtin_amdgcn_s_setprio(1); _Pragma("unroll") for (int m = 0; m < 4; ++m) _Pragma("unroll") for (int n = 0; n < 2; ++n) _Pragma("unroll") for (int k = 0; k < 2; ++k) \
        acc[bj][m][n] = __builtin_amdgcn_mfma_f32_16x16x32_bf16(Bt[n][k], At[m][k], acc[bj][m][n], 0, 0, 0); __builtin_amdgcn_s_setprio(0); } while (0)
#define PG8_WAIT_V(n) asm volatile("s_waitcnt vmcnt(" #n ")" ::: "memory")
#define PG8_WAIT_L(n) asm volatile("s_waitcnt lgkmcnt(" #n ")" ::: "memory")
#define PG8_BAR __builtin_amdgcn_s_barrier()
#define PG8_SCHED __builtin_amdgcn_sched_barrier(0)
    Unit cur, nxt; int ui = 0;
    if (!S.next(0, cur)) return;
    f32x4 acc[2][4][2];
#pragma unroll
    for (int a = 0; a < 2; ++a)
#pragma unroll
        for (int m = 0; m < 4; ++m)
#pragma unroll
            for (int n = 0; n < 2; ++n) acc[a][m][n] = (f32x4){0.f, 0.f, 0.f, 0.f};
    bf16x8 At[4][2], B0[2][2];
    const char* cA = (const char*)g.A + (size_t)cur.pm * hstepA + (size_t)cur.z * g.zA; const char* cB = (const char*)g.Bt + (size_t)cur.pn * 2 * hstepB + (size_t)cur.z * g.zB;
    PG8_STAGE(0, 0, cA, voffA); PG8_STAGE(0, 1, cB, voffB); PG8_STAGE(0, 2, cB + hstepB, voffB);
    if (wr == 1) PG8_BAR;
    PG8_WAIT_V(0); PG8_BAR;
    PG8_STAGE(1, 0, cA + kstep, voffA); PG8_STAGE(1, 1, cB + kstep, voffB); PG8_STAGE(1, 2, cB + hstepB + kstep, voffB);
    PG8_BAR;
    if constexpr (HasAhead<Epi>::value) E.load(cur, wr, wc, fr, fq);
    int cs = 0;
    for (;;) {
        const bool has_next = S.next(ui + 1, nxt);
        const char* nA = has_next ? (const char*)g.A + (size_t)nxt.pm * hstepA + (size_t)nxt.z * g.zA : cA; const char* nB = has_next ? (const char*)g.Bt + (size_t)nxt.pn * 2 * hstepB + (size_t)nxt.z * g.zB : cB;
        for (int t = 0; t < nt; ++t) {
            const bool over = (t + 2 >= nt);
            const char* a2 = uni(over ? nA + (size_t)(t + 2 - nt) * kstep : cA + (size_t)(t + 2) * kstep);
            const char* b2 = uni(over ? nB + (size_t)(t + 2 - nt) * kstep : cB + (size_t)(t + 2) * kstep);
            const int so = cs * M_STG; int ts = cs + 2; ts = ts >= 3 ? ts - 3 : ts;
            PG8_LDB(B0, so, 0); PG8_SCHED; PG8_LDA(At, so); PG8_STAGE(ts, 0, a2, voffA); PG8_STAGE(ts, 1, b2, voffB); PG8_STAGE(ts, 2, b2 + hstepB, voffB);
            if constexpr (HasAhead<Epi>::value) { if (t == 0) PG8_WAIT_V(14); else PG8_WAIT_V(6); }
            else {
                if (Epi::NPRE > 0 && t == nt - 2) E.prefetch(cur, wr, wc, fr, fq);
                if (Epi::NPRE > 0 && t >= nt - 2) { static_assert(Epi::NPRE == 0 || Epi::NPRE == 2, "wait literals"); PG8_WAIT_V(8); } else PG8_WAIT_V(6);
            }
            PG8_WAIT_L(0); PG8_BAR; PG8_MMA(0, At, B0); PG8_SCHED; PG8_LDB(B0, so, 1); PG8_WAIT_L(0); PG8_MMA(1, At, B0); PG8_BAR; PG8_SCHED;
            cs = (cs == 2) ? 0 : cs + 1;
        }
        if constexpr (ALIGN_EPI) { if (wr == 0) PG8_BAR; }
        if constexpr (HasAhead<Epi>::value) E.run(acc, cur, nxt, has_next, wr, wc, fr, fq); else E(acc, cur, wr, wc, fr, fq);
        if (!has_next) break;
#pragma unroll
        for (int a = 0; a < 2; ++a)
#pragma unroll
            for (int m = 0; m < 4; ++m)
#pragma unroll
                for (int n = 0; n < 2; ++n) acc[a][m][n] = (f32x4){0.f, 0.f, 0.f, 0.f};
        cur = nxt; cA = nA; cB = nB; ++ui;
        if constexpr (ALIGN_EPI) { if (wr == 1) PG8_BAR; }
    }
    PG8_WAIT_V(0);
    if constexpr (!ALIGN_EPI) { if (wr == 0) PG8_BAR; }
    PG8_BAR;
#undef PG8_STAGE
#undef PG8_LDA
#undef PG8_LDB
#undef PG8_MMA
#undef PG8_WAIT_V
#undef PG8_WAIT_L
#undef PG8_BAR
#undef PG8_SCHED
}
}
using pg8::Unit;

#define XB_TMO      128
#define XB_XCNT(j)  (256  + 64 * (j))
#define XB_XSUB(j)  (1280 + 64 * (j))
#define XB_XGEN(j)  (2304 + 64 * (j))
#define XB_TOP      3328
#define XB_TOPGEN   3392
#define XCD_BAR_WORDS 3456
#define XB_SPIN_CAP (1u << 18)
__device__ __forceinline__ unsigned xb_ld(unsigned* p)              { return __hip_atomic_load(p, __ATOMIC_RELAXED, __HIP_MEMORY_SCOPE_AGENT); }
__device__ __forceinline__ unsigned xb_add(unsigned* p, unsigned v) { return __hip_atomic_fetch_add(p, v, __ATOMIC_RELAXED, __HIP_MEMORY_SCOPE_AGENT); }
__device__ __forceinline__ unsigned xb_xcc_id() { return (unsigned)__builtin_amdgcn_s_getreg((3 << 11) | 20) & 0xFu; }
#define XB_SPIN(cond, bar) do { unsigned _sp = 0; while (cond) { __builtin_amdgcn_s_sleep(1); \
    if ((++_sp & 255u) == 0u) { if (xb_ld(&(bar)[XB_TMO])) break; if (_sp > XB_SPIN_CAP) { atomicAdd(&(bar)[XB_TMO], 1u); break; } } } } while (0)
struct XcdBarrier { unsigned* bar; unsigned x; volatile LAS unsigned* st; };
__device__ __forceinline__ XcdBarrier xcd_barrier_post(unsigned* bar, volatile LAS unsigned* st, int tid) {
    XcdBarrier b; b.bar = bar; b.x = xb_xcc_id(); b.st = st;
    if (tid == 0) (void)xb_add(&bar[XB_XCNT(b.x)], 1u);
    return b;
}
__device__ __forceinline__ void xcd_barrier_complete(unsigned* bar, unsigned x, unsigned& nloc, unsigned& nx) {
    const unsigned G = gridDim.x * gridDim.y * gridDim.z;
    unsigned sum, cnt, mine, sp = 0u;
    for (;;) {
        sum = 0u; cnt = 0u; mine = 0u;
#pragma unroll
        for (unsigned j = 0; j < 16; ++j) { const unsigned c = xb_ld(&bar[XB_XCNT(j)]); sum += c; cnt += (c > 0u) ? 1u : 0u; mine = (j == x) ? c : mine; }
        if (sum == G) break;
        __builtin_amdgcn_s_sleep(1);
        if ((++sp & 255u) == 0u) { if (xb_ld(&bar[XB_TMO])) break; if (sp > XB_SPIN_CAP) { atomicAdd(&bar[XB_TMO], 1u); break; } }
    }
    nloc = mine > 0u ? mine : 1u; nx = cnt > 0u ? cnt : 1u;
}
__device__ __forceinline__ void xcd_barrier(const XcdBarrier& b, int wave0) {
    asm volatile("s_waitcnt vmcnt(0)" ::: "memory");
    __syncthreads();
    unsigned zv = 0u; asm volatile("" : "+v"(zv));
    const int tid = wave0 * 64 + (int)__builtin_amdgcn_mbcnt_hi(~0u, __builtin_amdgcn_mbcnt_lo(~0u, zv));
    if (tid == 0) {
        unsigned* bar = b.bar; { size_t zo = 0; asm volatile("" : "+s"(zo)); bar += zo; }
        unsigned bx = b.x; asm volatile("" : "+s"(bx));
        __builtin_amdgcn_s_waitcnt(0);
        unsigned nloc = b.st[0], nx = b.st[1];
        if (nloc == 0u) { xcd_barrier_complete(bar, bx, nloc, nx); b.st[0] = nloc; b.st[1] = nx; }
        const unsigned old = xb_add(&bar[XB_XSUB(bx)], 1u);
        const unsigned gen = old / nloc;
        if (old + 1u == (gen + 1u) * nloc) {
            __builtin_amdgcn_fence(__ATOMIC_RELEASE, "agent");
            asm volatile("s_waitcnt vmcnt(0)" ::: "memory");
            const unsigned og = xb_add(&bar[XB_TOP], 1u);
            const unsigned tg = og / nx;
            if (og + 1u == (tg + 1u) * nx) xb_add(&bar[XB_TOPGEN], 1u);
            else XB_SPIN(xb_ld(&bar[XB_TOPGEN]) == tg, bar);
            __builtin_amdgcn_fence(__ATOMIC_ACQUIRE, "agent");
            xb_add(&bar[XB_XGEN(bx)], 1u);
            asm volatile("s_waitcnt vmcnt(0)" ::: "memory");
        } else {
            XB_SPIN(xb_ld(&bar[XB_XGEN(bx)]) == gen, bar);
            __builtin_amdgcn_fence(__ATOMIC_ACQUIRE, "agent");
            asm volatile("s_waitcnt vmcnt(0)" ::: "memory");
        }
    }
    __syncthreads();
}

struct Args { const float* in[27]; float* out; unsigned char* ws; int p_lo, p_hi; };
enum { I_X = 0, I_C, I_CTX, I_CCTX, I_WADA, I_BADA, I_WIN, I_BIN, I_WSGU, I_BSGU, I_WFNET, I_BFNET, I_RPB, I_ARE, I_AIM, I_LOGDT, I_BRE, I_BIM, I_CRE, I_CIM, I_S5D, I_WGLU, I_BGLU, I_WUP, I_WO, I_LNG, I_LNB };

struct Frame {
    LAS unsigned char* lds;
    int tid, lane, wave, wave0, G, bid, G0, bid0;
    unsigned char* ws; unsigned char* ws0;
    const float* const* in; int zi;
    float* out; float* out0;
};

__device__ __forceinline__ void refresh(Frame& F) {
    unsigned zv = 0u; asm volatile("" : "+v"(zv));
    const int ln = (int)__builtin_amdgcn_mbcnt_hi(~0u, __builtin_amdgcn_mbcnt_lo(~0u, zv));
    F.lane = ln; F.wave = F.wave0; F.tid = F.wave0 * 64 + ln;
    size_t z = 0; asm volatile("" : "+s"(z));
    { int zi = 0; asm volatile("" : "+s"(zi)); F.zi = zi; F.G = F.G0 + zi; F.bid = F.bid0 + zi; }
    F.ws = F.ws0 + z; F.out = F.out0 + z;
}
template <int MODE> __device__ __forceinline__ f32x2 act2(f32x2 v) {
    if (MODE == 0) return v;
    if (MODE == 1) return v * 0.12751743082459868f;
    f32x2 t;
    if (MODE == 2) t = v * (v * v * (-0.10294324849420653f) + (-2.302208198144325f));
    else t = v * (-1.4426950408889634f);
    f32x2 e; e.x = __builtin_amdgcn_exp2f(t.x); e.y = __builtin_amdgcn_exp2f(t.y);
    e = e + 1.0f;
    f32x2 r; r.x = __builtin_amdgcn_rcpf(e.x); r.y = __builtin_amdgcn_rcpf(e.y);
    if (MODE == 4) return r;
    return v * r;
}
constexpr int EPI_BIAS_LDS = 131072;
struct Epi1a {
    static constexpr bool PERM = true;
    bf16_t* Z; bf16_t* Xs; const float* bias; bf16_t* Zm;
    __device__ __forceinline__ void run_merge(const f32x4 (&acc)[2][2][4][2], const f32x4 (&bv)[2][2], const Unit& u, int wr, int wc, int fr, int fq) const {
        const int pnm = u.pn - 16;
        bf16_t* tb = Zm + ((size_t)(((pnm >> 3) * 144 + u.pm) * 8 + (pnm & 7))) * 65536 + (wr * 64 + fr) * 256 + wc * 32 + 8 * fq;
#pragma unroll
        for (int ai = 0; ai < 2; ++ai)
#pragma unroll
            for (int m = 0; m < 4; ++m)
#pragma unroll
                for (int bj = 0; bj < 2; ++bj) {
                    const f32x4 v0 = acc[ai][bj][m][0] + bv[bj][0], v1 = acc[ai][bj][m][1] + bv[bj][1];
                    const f32x2 o0 = act2<4>((f32x2){v0[0], v0[1]}), o1 = act2<4>((f32x2){v0[2], v0[3]}), o2 = act2<4>((f32x2){v1[0], v1[1]}), o3 = act2<4>((f32x2){v1[2], v1[3]});
                    u32x4 w; w.x = pk2(o0.x, o0.y); w.y = pk2(o1.x, o1.y); w.z = pk2(o2.x, o2.y); w.w = pk2(o3.x, o3.y);
                    *(u32x4*)(tb + (ai * 128 + m * 16) * 256 + bj * 128) = w;
                }
    }
    template <int MODE, bool ISU> __device__ __forceinline__ void run(const f32x4 (&acc)[2][2][4][2], const f32x4 (&bv)[2][2], const Unit& u, int wr, int wc, int fr, int fq, int colshift) const {
        const int row0 = u.pm * 256 + wr * 64 + fr, col0 = u.pn * 256 + wc * 32 + 8 * fq;
#pragma unroll
        for (int ai = 0; ai < 2; ++ai)
#pragma unroll
            for (int m = 0; m < 4; ++m) {
                const int row = row0 + ai * 128 + m * 16;
                bf16_t* rowp;
                if (ISU) {
                    int xsrow, s;
                    if (row < MX) { const int b = row >> 11, n = row & 2047; xsrow = b * 64 + (n >> 5); s = n & 31; }
                    else { const int mm = row - MX, b = mm >> 8, n = mm & 255; xsrow = 1024 + b * 8 + (n >> 5); s = n & 31; }
                    rowp = Xs + (size_t)xsrow * XS_K + s * 16;
                } else rowp = Z + (size_t)row * LDZ;
#pragma unroll
                for (int bj = 0; bj < 2; ++bj) {
                    const f32x4 v0 = acc[ai][bj][m][0] + bv[bj][0], v1 = acc[ai][bj][m][1] + bv[bj][1];
                    const f32x2 o0 = act2<MODE>((f32x2){v0[0], v0[1]}), o1 = act2<MODE>((f32x2){v0[2], v0[3]}), o2 = act2<MODE>((f32x2){v1[0], v1[1]}), o3 = act2<MODE>((f32x2){v1[2], v1[3]});
                    u32x4 w; w.x = pk2(o0.x, o0.y); w.y = pk2(o1.x, o1.y); w.z = pk2(o2.x, o2.y); w.w = pk2(o3.x, o3.y);
                    const int col = col0 + bj * 128 - colshift;
                    if (ISU) *(u32x4*)(rowp + (size_t)(col >> 4) * ((size_t)XS_ROWS * XS_K) + (col & 15)) = w;
                    else *(u32x4*)(rowp + col) = w;
                }
            }
    }
    __device__ __forceinline__ void load_bias(f32x4 (&bv)[2][2], const LAS unsigned char* bl, int wc, int fq) const {
#pragma unroll
        for (int bj = 0; bj < 2; ++bj)
#pragma unroll
            for (int n = 0; n < 2; ++n) bv[bj][n] = *(const LAS f32x4*)(bl + (wc * 32 + 8 * fq + bj * 128 + 4 * n) * 4);
    }
    __device__ __forceinline__ void operator()(const f32x4 (&acc)[2][2][4][2], const f32x4 (&bv)[2][2], const Unit& u, int wr, int wc, int fr, int fq) const {
        const int pn = u.pn;
        if (pn >= 16 && pn < 48) run_merge(acc, bv, u, wr, wc, fr, fq);
        else if (pn >= 8 && pn < 16) run<3, false>(acc, bv, u, wr, wc, fr, fq, 0);
        else if (pn >= 6 && pn < 8) run<2, false>(acc, bv, u, wr, wc, fr, fq, 0);
        else if (pn >= 4 && pn < 6) run<1, false>(acc, bv, u, wr, wc, fr, fq, 0);
        else if (pn < 2) run<0, true>(acc, bv, u, wr, wc, fr, fq, 0);
        else run<0, false>(acc, bv, u, wr, wc, fr, fq, pn >= 48 ? 12288 : 0);
    }
};
struct Epi1b {
    static constexpr bool PERM = true;
    bf16_t* Vt; bf16_t* vT; const float* bias;
    __device__ __forceinline__ void load_bias(f32x4 (&bv)[2][2], const LAS unsigned char* bl, int wr, int fr) const {
#pragma unroll
        for (int ai = 0; ai < 2; ++ai)
#pragma unroll
            for (int m = 0; m < 4; ++m) bv[ai][0][m] = *(const LAS float*)(bl + (wr * 64 + fr + ai * 128 + m * 16) * 4);
    }
    template <bool ISG> __device__ __forceinline__ void run(const f32x4 (&acc)[2][2][4][2], const f32x4 (&bv)[2][2], const Unit& u, int wr, int wc, int fr, int fq) const {
        const int f0 = u.pm * 256 + wr * 64 + fr, t0 = wc * 32 + 8 * fq;
        const int pn = u.pn;
#pragma unroll
        for (int ai = 0; ai < 2; ++ai)
#pragma unroll
            for (int m = 0; m < 4; ++m) {
                const int f = f0 + ai * 128 + m * 16; const float bf = bv[ai][0][m];
                bf16_t* rowp = (ISG ? vT + (size_t)(f - 512) * MT : Vt + (size_t)f * MT) + pn * 256;
#pragma unroll
                for (int bj = 0; bj < 2; ++bj) {
                    float o[8];
#pragma unroll
                    for (int j = 0; j < 8; ++j) { const float x = acc[ai][bj][m][j >> 2][j & 3] + bf; o[j] = ISG ? gelu_t(x) : x; }
                    u32x4 w; w.x = pk2(o[0], o[1]); w.y = pk2(o[2], o[3]); w.z = pk2(o[4], o[5]); w.w = pk2(o[6], o[7]);
                    *(u32x4*)(rowp + t0 + bj * 128) = w;
                }
            }
    }
    __device__ __forceinline__ void operator()(const f32x4 (&acc)[2][2][4][2], const f32x4 (&bv)[2][2], const Unit& u, int wr, int wc, int fr, int fq) const {
        if (u.pm >= 2) run<true>(acc, bv, u, wr, wc, fr, fq); else run<false>(acc, bv, u, wr, wc, fr, fq);
    }
};
struct Epi1ab {
    static constexpr bool PERM = true;
    static constexpr bool HAS_PRE = true;
    Epi1a a; Epi1b b;
    __device__ __forceinline__ void pre(const Unit& u, LAS unsigned char* lds, int wid, int lane, int sl) const {
        if (wid != 0) return;
        const float* src = (u.z == 0 ? a.bias + u.pn * 256 : b.bias + u.pm * 256) + lane * 4;
        __builtin_amdgcn_global_load_lds((const unsigned*)src, (LAS unsigned*)(lds + EPI_BIAS_LDS + sl * 1024), 16, 0, 0);
    }
    __device__ __forceinline__ void operator()(const f32x4 (&acc)[2][2][4][2], const Unit& u, int wr, int wc, int fr, int fq) const {
        f32x4 bv[2][2];
        const LAS unsigned char* bl = lds0 + EPI_BIAS_LDS + slot * 1024;
        if (u.z == 0) { a.load_bias(bv, bl, wc, fq); a(acc, bv, u, wr, wc, fr, fq); }
        else { bv[0][1] = (f32x4){0.f, 0.f, 0.f, 0.f}; bv[1][1] = bv[0][1]; b.load_bias(bv, bl, wr, fr); b(acc, bv, u, wr, wc, fr, fq); }
    }
    LAS unsigned char* lds0; int slot;
};
struct EpiB1 {
    static constexpr bool PERM = true;
    bf16_t* Ptx; bf16_t* Ptc;
    __device__ __forceinline__ void operator()(const f32x4 (&acc)[2][2][4][2], const Unit& u, int wr, int wc, int fr, int fq) const {
        const int f0 = u.pm * 256 + wr * 64 + fr, t0 = wc * 32 + 8 * fq;
        const int pn = u.pn;
#pragma unroll
        for (int ai = 0; ai < 2; ++ai)
#pragma unroll
            for (int m = 0; m < 4; ++m) {
                const int f = f0 + ai * 128 + m * 16;
                bf16_t* rowp;
                if (pn < 128) rowp = Ptx + ((size_t)((pn >> 3) * 1024 + f)) * 2048 + (pn & 7) * 256;
                else rowp = Ptc + ((size_t)((pn - 128) * 1024 + f)) * 256;
#pragma unroll
                for (int bj = 0; bj < 2; ++bj) {
                    const f32x4 v0 = acc[ai][bj][m][0], v1 = acc[ai][bj][m][1];
                    u32x4 w; w.x = pk2(v0[0], v0[1]); w.y = pk2(v0[2], v0[3]); w.z = pk2(v1[0], v1[1]); w.w = pk2(v1[2], v1[3]);
                    *(u32x4*)(rowp + t0 + bj * 128) = w;
                }
                asm volatile("" ::: "memory");
            }
    }
};
template <bool CTX> struct EpiFB2 {
    static constexpr bool PERM = true;
    bf16_t* Y; const bf16_t* Z; const float* bfn;
    __device__ __forceinline__ void operator()(const f32x4 (&acc)[2][2][4][2], const Unit& u, int wr, int wc, int fr, int fq) const {
        const int n0 = u.pm * 256 + wr * 64 + fr, cg0 = u.pn * 256 + wc * 32 + 8 * fq;
#pragma unroll
        for (int bj = 0; bj < 2; ++bj) {
            const int cg = cg0 + bj * 128, b = cg >> 9, col = cg & 511;
            const f32x4 b0 = *(const f32x4*)(bfn + col), b1 = *(const f32x4*)(bfn + col + 4);
#pragma unroll
            for (int ai = 0; ai < 2; ++ai)
#pragma unroll
                for (int m = 0; m < 4; ++m) {
                    const int n = n0 + ai * 128 + m * 16;
                    const size_t tok = CTX ? (size_t)(MX + b * CTXL + n) : (size_t)(b * SEQ + n);
                    const u32x4 gt = *(const u32x4*)(Z + tok * LDZ + ZC_GATE + 512 + col);
                    const f32x4 v0 = acc[ai][bj][m][0] + b0, v1 = acc[ai][bj][m][1] + b1;
                    u32x4 w; w.x = pk2(v0[0] * bflo(gt.x), v0[1] * bfhi(gt.x)); w.y = pk2(v0[2] * bflo(gt.y), v0[3] * bfhi(gt.y));
                    w.z = pk2(v1[0] * bflo(gt.z), v1[1] * bfhi(gt.z)); w.w = pk2(v1[2] * bflo(gt.w), v1[3] * bfhi(gt.w));
                    *(u32x4*)(Y + tok * DM + 512 + col) = w;
                    asm volatile("" ::: "memory");
                }
        }
    }
};
struct EpiS5E {
    static constexpr bool PERM = false;
    float* E;
    __device__ __forceinline__ void operator()(const f32x4 (&acc)[2][2][4][2], const Unit& u, int wr, int wc, int fr, int fq) const {
        const int row0 = u.pm * 256 + wr * 64 + fr, col0 = wc * 32 + 4 * fq;
#pragma unroll
        for (int ai = 0; ai < 2; ++ai)
#pragma unroll
            for (int m = 0; m < 4; ++m) {
                const int row = row0 + ai * 128 + m * 16;
                if (row < 1152) { float* rp = E + ((size_t)u.z * XS_ROWS + row) * 256 + col0;
#pragma unroll
                    for (int bj = 0; bj < 2; ++bj)
#pragma unroll
                        for (int n = 0; n < 2; ++n) *(f32x4*)(rp + bj * 128 + n * 16) = acc[ai][bj][m][n]; }
            }
    }
};
struct EpiS5Y {
    static constexpr bool PERM = true;
    bf16_t* Yd;
    __device__ __forceinline__ void operator()(const f32x4 (&acc)[2][2][4][2], const Unit& u, int wr, int wc, int fr, int fq) const {
        const int row0 = u.pm * 256 + wr * 64 + fr, cc0 = u.pn * 256 + wc * 32 + 8 * fq;
#pragma unroll
        for (int ai = 0; ai < 2; ++ai)
#pragma unroll
            for (int m = 0; m < 4; ++m) {
                const int row = row0 + ai * 128 + m * 16;
                if (row < 1152) {
                    int tokb;
                    if (row < 1024) tokb = (row >> 6) * SEQ + (row & 63) * 32; else { const int r2 = row - 1024; tokb = MX + (r2 >> 3) * CTXL + (r2 & 7) * 32; }
#pragma unroll
                    for (int bj = 0; bj < 2; ++bj) {
                        const int cc = cc0 + bj * 128, t = cc >> 4, hh = cc & 15;
                        float o[8];
#pragma unroll
                        for (int j = 0; j < 8; ++j) o[j] = gelu_t(acc[ai][bj][m][j >> 2][j & 3]);
                        u32x4 w; w.x = pk2(o[0], o[1]); w.y = pk2(o[2], o[3]); w.z = pk2(o[4], o[5]); w.w = pk2(o[6], o[7]);
                        *(u32x4*)(Yd + (size_t)(tokb + t) * 512 + u.z * 16 + hh) = w;
                    }
                }
            }
    }
};
struct EpiGLU {
    static constexpr bool PERM = true;
    bf16_t* Y; const bf16_t* Yd; const bf16_t* Z; const float* bg;
    __device__ __forceinline__ void operator()(const f32x4 (&acc)[2][2][4][2], const Unit& u, int wr, int wc, int fr, int fq) const {
        const int row0 = u.pm * 256 + wr * 64 + fr, col0 = u.pn * 256 + wc * 32 + 8 * fq;
#pragma unroll
        for (int bj = 0; bj < 2; ++bj) {
            const int col = col0 + bj * 128;
            const f32x4 b0 = *(const f32x4*)(bg + col), b1 = *(const f32x4*)(bg + col + 4);
#pragma unroll
            for (int ai = 0; ai < 2; ++ai)
#pragma unroll
                for (int m = 0; m < 4; ++m) {
                    const size_t tok = (size_t)(row0 + ai * 128 + m * 16);
                    const u32x4 yv = *(const u32x4*)(Yd + tok * 512 + col);
                    const u32x4 gt = *(const u32x4*)(Z + tok * LDZ + ZC_GATE + 1536 + col);
                    const f32x4 v0 = acc[ai][bj][m][0] + b0, v1 = acc[ai][bj][m][1] + b1;
                    u32x4 w;
                    w.x = pk2(bflo(yv.x) * sigm(v0[0]) * bflo(gt.x), bfhi(yv.x) * sigm(v0[1]) * bfhi(gt.x));
                    w.y = pk2(bflo(yv.y) * sigm(v0[2]) * bflo(gt.y), bfhi(yv.y) * sigm(v0[3]) * bfhi(gt.y));
                    w.z = pk2(bflo(yv.z) * sigm(v1[0]) * bflo(gt.z), bfhi(yv.z) * sigm(v1[1]) * bfhi(gt.z));
                    w.w = pk2(bflo(yv.w) * sigm(v1[2]) * bflo(gt.w), bfhi(yv.w) * sigm(v1[3]) * bfhi(gt.w));
                    *(u32x4*)(Y + tok * DM + 1536 + col) = w;
                    asm volatile("" ::: "memory");
                }
        }
    }
};
struct EpiUP {
    static constexpr bool PERM = true; static constexpr int NPRE = 2;
    bf16_t* Mo; const bf16_t* Z;
    f32x4 ms[2][4][2];
    u32x4 sg0[2];
    __device__ __forceinline__ void prefetch(const Unit& u, int wr, int wc, int fr, int fq) {
        const bf16_t* p = Z + ((size_t)((u.z * 144 + (u.pm >> 1)) * 8 + u.pn)) * 65536 + ((u.pm & 1) * 128 + wr * 64 + fr) * 256 + wc * 32 + 8 * fq;
#pragma unroll
        for (int m = 0; m < 2; ++m) sg0[m] = *(const u32x4*)(p + (m * 16) * 256);
    }
    __device__ __forceinline__ void operator()(const f32x4 (&acc)[2][4][2], const Unit& u, int wr, int wc, int fr, int fq) {
        const int row0 = u.pm * 128 + wr * 64 + fr, col0 = u.pn * 256 + wc * 32 + 8 * fq;
        const int i = u.z;
        u32x4 sg1[4], sg2[2];
        const bf16_t* tb = Z + ((size_t)((i * 144 + (u.pm >> 1)) * 8 + u.pn)) * 65536 + ((u.pm & 1) * 128 + wr * 64 + fr) * 256 + wc * 32 + 8 * fq;
#pragma unroll
        for (int m = 0; m < 2; ++m) sg2[m] = *(const u32x4*)(tb + ((m + 2) * 16) * 256);
#pragma unroll
        for (int m = 0; m < 4; ++m) sg1[m] = *(const u32x4*)(tb + (m * 16) * 256 + 128);
#pragma unroll
        for (int bj = 0; bj < 2; ++bj) {
            const int col = col0 + bj * 128;
#pragma unroll
            for (int m = 0; m < 4; ++m) {
                f32x4 t0 = acc[bj][m][0], t1 = acc[bj][m][1]; const u32x4 g4 = bj == 0 ? (m < 2 ? sg0[m & 1] : sg2[m & 1]) : sg1[m];
                t0[0] *= bflo(g4.x); t0[1] *= bfhi(g4.x); t0[2] *= bflo(g4.y); t0[3] *= bfhi(g4.y);
                t1[0] *= bflo(g4.z); t1[1] *= bfhi(g4.z); t1[2] *= bflo(g4.w); t1[3] *= bfhi(g4.w);
                if (i > 0) { t0 += ms[bj][m][0]; t1 += ms[bj][m][1]; }
                ms[bj][m][0] = t0; ms[bj][m][1] = t1;
                if (i == 3) { u32x4 w; w.x = pk2(t0[0], t0[1]); w.y = pk2(t0[2], t0[3]); w.z = pk2(t1[0], t1[1]); w.w = pk2(t1[2], t1[3]);
                    *(u32x4*)(Mo + (size_t)(row0 + m * 16) * DM + col) = w; }
            }
        }
    }
};
constexpr int EPI_OUT_LDS = EPI_BIAS_LDS + 2048;
struct EpiOUT {
    static constexpr bool PERM = false;
    static constexpr bool HAS_PRE = true;
    const float* xsrc; const float* csrc; float* xdst; float* cdst; const float* ada;
    const float* gp; const float* bp; const float* rsp; bool first;
    LAS unsigned char* lds0; int slot;
    __device__ __forceinline__ void pre(const Unit& u, LAS unsigned char* lds, int wid, int lane, int sl) const {
        if (wid >= 3) return;
        const int bidx = u.pm < 128 ? (u.pm >> 3) : 16;
        const float* src = (wid == 0 ? ada + (size_t)bidx * 6144 + 4096 : (wid == 1 ? gp : bp)) + u.pn * 256 + lane * 4;
        __builtin_amdgcn_global_load_lds((const unsigned*)src, (LAS unsigned*)(lds + EPI_OUT_LDS + sl * 3072 + wid * 1024), 16, 0, 0);
    }
    __device__ __forceinline__ void operator()(f32x4 (&acc)[2][2][4][2], const Unit& u, int wr, int wc, int fr, int fq) const {
        const bool isx = u.pm < 128;
        const float* src = isx ? xsrc : csrc - (size_t)MX * DM; float* dst = isx ? xdst : cdst - (size_t)MX * DM;
        const int row0 = u.pm * 256 + wr * 64 + fr, col0 = u.pn * 256 + wc * 32 + 4 * fq;
        const LAS unsigned char* vl = lds0 + EPI_OUT_LDS + slot * 3072 + (wc * 32 + 4 * fq) * 4;
        f32x4 xv[3][2][2]; f32x2 st[3];
#define EPO_ISSUE(g) do { const int row = row0 + ((g) >> 2) * 128 + ((g) & 3) * 16; const size_t off = (size_t)row * DM + col0; \
            { const f32x2 t_ = *(const f32x2*)(rsp + (size_t)row * 2); st[(g) % 3].x = first ? 0.f : t_.x; st[(g) % 3].y = first ? 1.f : t_.y; }        \
            _Pragma("unroll") for (int bj = 0; bj < 2; ++bj) _Pragma("unroll") for (int n = 0; n < 2; ++n) xv[(g) % 3][bj][n] = *(const f32x4*)(src + off + bj * 128 + n * 16); } while (0)
        EPO_ISSUE(0); EPO_ISSUE(1); EPO_ISSUE(2);
        asm volatile("" ::: "memory");
#pragma unroll
        for (int bj = 0; bj < 2; ++bj)
#pragma unroll
            for (int n = 0; n < 2; ++n) {
                const f32x4 gvv = *(const LAS f32x4*)(vl + bj * 512 + n * 64);
                const f32x4 bpp = *(const LAS f32x4*)(vl + 2048 + bj * 512 + n * 64) * (first ? 0.f : DN_ALPHA);
#pragma unroll
                for (int ai = 0; ai < 2; ++ai)
#pragma unroll
                    for (int m = 0; m < 4; ++m) acc[ai][bj][m][n] = gvv * acc[ai][bj][m][n] + bpp;
            }
        f32x4 gpv[2][2];
#pragma unroll
        for (int bj = 0; bj < 2; ++bj)
#pragma unroll
            for (int n = 0; n < 2; ++n) { const f32x4 t = *(const LAS f32x4*)(vl + 1024 + bj * 512 + n * 64);
#pragma unroll
                for (int e = 0; e < 4; ++e) gpv[bj][n][e] = first ? DN_ALPHA : t[e] * DN_ALPHA; }
#pragma unroll
        for (int g = 0; g < 8; ++g) {
            const int ai = g >> 2, m = g & 3;
            const int row = row0 + ai * 128 + m * 16; const size_t off = (size_t)row * DM + col0;
            const float mu = st[g % 3].x, ar = st[g % 3].y;
#pragma unroll
            for (int bj = 0; bj < 2; ++bj)
#pragma unroll
                for (int n = 0; n < 2; ++n) *(f32x4*)(dst + off + bj * 128 + n * 16) = (xv[g % 3][bj][n] - mu) * ar * gpv[bj][n] + acc[ai][bj][m][n];
            asm volatile("" ::: "memory");
            if (g + 3 < 8) { EPO_ISSUE(g + 3); asm volatile("" ::: "memory"); }
        }
#undef EPO_ISSUE
    }
};

struct EpiOUTh {
    static constexpr bool PERM = false;
    EpiOUT e;
    __device__ __forceinline__ void operator()(const f32x4 (&acc)[2][4][2], const Unit& u, int wr, int wc, int fr, int fq) {
        const bool isx = u.pm < 128;
        const int bidx = isx ? (u.pm >> 3) : 16;
        const float* src = isx ? e.xsrc : e.csrc - (size_t)MX * DM; float* dst = isx ? e.xdst : e.cdst - (size_t)MX * DM;
        const int row0 = u.pm * 256 + wr * 64 + fr, col0 = u.pn * 128 + wc * 32 + 4 * fq;
        f32x4 gv[2], gpv[2], bpv[2];
#pragma unroll
        for (int n = 0; n < 2; ++n) { const int c = col0 + n * 16;
            gv[n] = *(const f32x4*)(e.ada + (size_t)bidx * 6144 + 4096 + c);
            { const f32x4 tg = *(const f32x4*)(e.gp + c), tb = *(const f32x4*)(e.bp + c); const float ka = e.first ? 0.f : DN_ALPHA, kc = e.first ? DN_ALPHA : 0.f; gpv[n] = tg * ka + kc; bpv[n] = tb * ka; } }
        f32x4 xv[2][4][2]; f32x2 st[2][4];
#pragma unroll
        for (int ai = 0; ai < 2; ++ai)
#pragma unroll
            for (int m = 0; m < 4; ++m) {
                const int row = row0 + ai * 128 + m * 16; const size_t off = (size_t)row * DM + col0;
                const f32x2 t = *(const f32x2*)(e.rsp + (size_t)row * 2); st[ai][m].x = e.first ? 0.f : t.x; st[ai][m].y = e.first ? 1.f : t.y;
#pragma unroll
                for (int n = 0; n < 2; ++n) xv[ai][m][n] = *(const f32x4*)(src + off + n * 16);
            }
        asm volatile("" ::: "memory");
#pragma unroll
        for (int ai = 0; ai < 2; ++ai)
#pragma unroll
            for (int m = 0; m < 4; ++m) {
                const int row = row0 + ai * 128 + m * 16; const size_t off = (size_t)row * DM + col0;
                const float mu = st[ai][m].x, ar = st[ai][m].y;
#pragma unroll
                for (int n = 0; n < 2; ++n) *(f32x4*)(dst + off + n * 16) = (xv[ai][m][n] - mu) * ar * gpv[n] + bpv[n] + gv[n] * acc[ai][m][n];
            }
    }
};

__device__ __forceinline__ void transpose_item(const float* W, int ldw, int c0, int k0, bf16_t* WT, int K, int r0, LAS float* scr, int lane) {
    float tv[32];
#pragma unroll
    for (int i = 0; i < 32; ++i) tv[i] = W[(size_t)(k0 + 2 * i + (lane >> 5)) * ldw + c0 + (lane & 31)];
#pragma unroll
    for (int i = 0; i < 32; ++i) scr[(2 * i + (lane >> 5)) * 33 + (lane & 31)] = tv[i];
    LDS_WAIT(); asm volatile("" ::: "memory");
    const int c = lane & 7;
#pragma unroll
    for (int j = 0; j < 4; ++j) { const int n = (lane >> 3) + 8 * j; const LAS float* s = scr + (8 * c) * 33 + n;
        u32x4 o; o.x = pk2(s[0 * 33], s[1 * 33]); o.y = pk2(s[2 * 33], s[3 * 33]); o.z = pk2(s[4 * 33], s[5 * 33]); o.w = pk2(s[6 * 33], s[7 * 33]);
        *(u32x4*)(WT + (size_t)(r0 + n) * K + k0 + 8 * c) = o; }
    LDS_WAIT(); asm volatile("" ::: "memory");
}
__device__ __forceinline__ int win_src_col(int j) {
    if (j < 1024) return j;
    if (j < 1536) return OFF_C_Q + (j - 1024);
    if (j < 2048) return OFF_A_UV + (j - 1536);
    if (j < 4096) return OFF_GATE + (j - 2048);
    if (j < 12288) return OFF_MERGE + (j - 4096);
    return OFF_B + (j - 12288);
}
__device__ __forceinline__ float hw_sin_rev(float rev) { return __builtin_amdgcn_sinf(rev); }
__device__ __forceinline__ float hw_cos_rev(float rev) { return __builtin_amdgcn_cosf(rev); }

__device__ __forceinline__ void s5_setup_unit(Frame& F, int l, int uidx) {
    const int par = l & 1, g = uidx >> 2, q = uidx & 3;
    LAS float* pw = (LAS float*)(F.lds);
    LAS float* bb = (LAS float*)(F.lds + 33792);
    LAS float* cc = (LAS float*)(F.lds + 50176);
    LAS float* kt = (LAS float*)(F.lds + 66560);
    const float* a_re = F.in[F.zi + I_ARE] + (size_t)l * 2 * 32 * 64, *a_im = F.in[F.zi + I_AIM] + (size_t)l * 2 * 32 * 64, *ldt = F.in[F.zi + I_LOGDT] + (size_t)l * 2 * 32;
    const float* b_re = F.in[F.zi + I_BRE] + (size_t)l * 2 * 32 * 64 * 16, *b_im = F.in[F.zi + I_BIM] + (size_t)l * 2 * 32 * 64 * 16;
    const float* c_re = F.in[F.zi + I_CRE] + (size_t)l * 2 * 32 * 16 * 64, *c_im = F.in[F.zi + I_CIM] + (size_t)l * 2 * 32 * 16 * 64;
    const float* dsk = F.in[F.zi + I_S5D] + (size_t)l * 512 + g * 16;
    float* AT = (float*)(F.ws + WS_AT + (size_t)par * AT_STRIDE);
    LAS float* dsl = (LAS float*)(F.lds + 132096);
    if (F.tid < 16) dsl[F.tid] = dsk[F.tid];
    float lr2[2], li2[2];
#pragma unroll
    for (int d = 0; d < 2; ++d) { const float dt = expf(ldt[d * 32 + g]); const int p = F.tid & 63; lr2[d] = a_re[(d * 32 + g) * 64 + p] * dt; li2[d] = a_im[(d * 32 + g) * 64 + p] * dt; }
    for (int it = F.tid; it < 2 * 64 * 33; it += 512) {
        const int d = it / (64 * 33), r = it % (64 * 33), j = r / 64, p = r % 64;
        const float lr = d == 0 ? lr2[0] : lr2[1], li = d == 0 ? li2[0] : li2[1];
        const float mag = expf((float)j * lr);
        double rev = (double)j * (double)li * 0.15915494309189535; rev -= rint(rev);
        const float cr = hw_cos_rev((float)rev), sr = hw_sin_rev((float)rev);
        pw[((d * 33 + j) * 64 + p) * 2 + 0] = mag * cr; pw[((d * 33 + j) * 64 + p) * 2 + 1] = mag * sr;
        if (j == 32 && q == 0) { AT[((g * 2 + d) * 64 + p) * 2 + 0] = mag * cr; AT[((g * 2 + d) * 64 + p) * 2 + 1] = mag * sr; }
    }
    for (int it = F.tid; it < 2 * 64 * 16; it += 512) {
        const int d = it / 1024, r = it % 1024, p = r / 16, h = r % 16;
        const float dt = expf(ldt[d * 32 + g]);
        const float are = a_re[(d * 32 + g) * 64 + p], aim = a_im[(d * 32 + g) * 64 + p];
        const float lr = are * dt, li = aim * dt;
        const float mag = expf(lr);
        double rev = (double)li * 0.15915494309189535; rev -= rint(rev);
        const float abr = mag * hw_cos_rev((float)rev), abi = mag * hw_sin_rev((float)rev);
        const float den = are * are + aim * aim;
        const float fre = ((abr - 1.0f) * are + abi * aim) / den, fim = (abi * are - (abr - 1.0f) * aim) / den;
        const float bre = b_re[((size_t)(d * 32 + g) * 64 + p) * 16 + h], bim = b_im[((size_t)(d * 32 + g) * 64 + p) * 16 + h];
        bb[it * 2 + 0] = fre * bre - fim * bim; bb[it * 2 + 1] = fre * bim + fim * bre;
    }
    for (int it = F.tid; it < 2 * 16 * 64; it += 512) {
        const int d = it / 1024, r = it % 1024, hp = r / 64, p = r % 64;
        cc[((d * 64 + p) * 16 + hp) * 2 + 0] = c_re[((size_t)(d * 32 + g) * 16 + hp) * 64 + p]; cc[((d * 64 + p) * 16 + hp) * 2 + 1] = c_im[((size_t)(d * 32 + g) * 16 + hp) * 64 + p];
    }
    __syncthreads();
    for (int it = F.tid; it < 2 * 32 * 16; it += 512) {
        const int d = it / 512, r = it % 512, j = r / 16, hp = r % 16;
        float sacc[16];
#pragma unroll
        for (int h = 0; h < 16; ++h) sacc[h] = 0.f;
#pragma unroll 2
        for (int p = 0; p < 64; ++p) {
            const f32x2 pv = *(const LAS f32x2*)(pw + ((d * 33 + j) * 64 + p) * 2), cv = *(const LAS f32x2*)(cc + ((d * 64 + p) * 16 + hp) * 2);
            const float wr_ = cv.x * pv.x - cv.y * pv.y, wi_ = cv.x * pv.y + cv.y * pv.x;
            const LAS f32x4* bp = (const LAS f32x4*)(bb + ((d * 64 + p) * 16) * 2);
#pragma unroll
            for (int h2 = 0; h2 < 8; ++h2) { const f32x4 b2 = bp[h2]; sacc[2 * h2] += wr_ * b2.x - wi_ * b2.y; sacc[2 * h2 + 1] += wr_ * b2.z - wi_ * b2.w; }
        }
#pragma unroll
        for (int h = 0; h < 16; ++h) kt[(d * 32 + j) * 256 + hp * 16 + h] = sacc[h];
    }
    __syncthreads();
    bf16_t* W3 = (bf16_t*)(F.ws + WS_W3 + (size_t)par * W3_STRIDE) + (size_t)g * 512 * 768;
    for (int it = F.tid; it < 128 * 96; it += 512) {
        const int row = 128 * q + it / 96, k0 = (it % 96) * 8, t = row >> 4, hp = row & 15;
        float v[8];
        if (k0 < 512) { const int s_ = k0 >> 4, h0 = k0 & 15;
#pragma unroll
            for (int e = 0; e < 8; ++e) v[e] = 0.f;
            if (s_ <= t) { const LAS f32x4* kp = (const LAS f32x4*)(kt + (0 * 32 + (t - s_)) * 256 + hp * 16 + h0); const f32x4 a0 = kp[0], a1 = kp[1];
                v[0] += a0[0]; v[1] += a0[1]; v[2] += a0[2]; v[3] += a0[3]; v[4] += a1[0]; v[5] += a1[1]; v[6] += a1[2]; v[7] += a1[3]; }
            if (s_ >= t) { const LAS f32x4* kp = (const LAS f32x4*)(kt + (1 * 32 + (s_ - t)) * 256 + hp * 16 + h0); const f32x4 a0 = kp[0], a1 = kp[1];
                v[0] += a0[0]; v[1] += a0[1]; v[2] += a0[2]; v[3] += a0[3]; v[4] += a1[0]; v[5] += a1[1]; v[6] += a1[2]; v[7] += a1[3]; }
            if (s_ == t) { const float dv = dsl[hp];
#pragma unroll
                for (int e = 0; e < 8; ++e) v[e] += (h0 + e == hp) ? dv : 0.f; }
        } else { const int d = (k0 - 512) >> 7, ri = ((k0 - 512) >> 6) & 1, p0 = k0 & 63;
            const int j = d == 0 ? (t + 1) : (32 - t);
#pragma unroll
            for (int e = 0; e < 8; ++e) { const int p = p0 + e;
                const f32x2 pv = *(const LAS f32x2*)(pw + ((d * 33 + j) * 64 + p) * 2), cv = *(const LAS f32x2*)(cc + ((d * 64 + p) * 16 + hp) * 2);
                v[e] = ri == 0 ? (cv.x * pv.x - cv.y * pv.y) : -(cv.x * pv.y + cv.y * pv.x); }
        }
        u32x4 o; o.x = pk2(v[0], v[1]); o.y = pk2(v[2], v[3]); o.z = pk2(v[4], v[5]); o.w = pk2(v[6], v[7]);
        *(u32x4*)(W3 + (size_t)row * 768 + k0) = o;
    }
    bf16_t* Me = (bf16_t*)(F.ws + (par ? WS_MEND2 : WS_MEND)) + (size_t)g * 256 * 512;
    for (int it = F.tid; it < 64 * 64; it += 512) {
        const int row = 64 * q + it / 64, k0 = (it % 64) * 8, d = row >> 7, ri = (row >> 6) & 1, p = row & 63;
        const int s_ = k0 >> 4, h0 = k0 & 15, j = d == 0 ? (31 - s_) : s_;
        const f32x2 pv = *(const LAS f32x2*)(pw + ((d * 33 + j) * 64 + p) * 2);
        float v[8];
#pragma unroll
        for (int e = 0; e < 8; ++e) { const f32x2 bv = *(const LAS f32x2*)(bb + ((d * 64 + p) * 16 + h0 + e) * 2);
            v[e] = ri == 0 ? (pv.x * bv.x - pv.y * bv.y) : (pv.x * bv.y + pv.y * bv.x); }
        u32x4 o; o.x = pk2(v[0], v[1]); o.y = pk2(v[2], v[3]); o.z = pk2(v[4], v[5]); o.w = pk2(v[6], v[7]);
        *(u32x4*)(Me + (size_t)row * 512 + k0) = o;
    }
    __syncthreads();
}
__device__ __forceinline__ void fourier_setup_unit(Frame& F, int l, int uidx) {
    const int g = uidx >> 3, cs = (uidx >> 2) & 1, dq = uidx & 3;
    LAS float* tr = (LAS float*)(F.lds);
    const float* wf = F.in[F.zi + I_WFNET] + ((size_t)l * 4 + g) * 128 * 128;
    if (F.tid < 128) { const float rev = (float)F.tid * (1.0f / 128.0f); tr[F.tid] = (cs == 0 ? hw_cos_rev(rev) : hw_sin_rev(rev)) * 0.08838834764831845f; }
    LAS float* wl = (LAS float*)(F.lds + 1024);
#pragma unroll
    for (int e8 = 0; e8 < 8; ++e8) { const int e = F.tid + 512 * e8; wl[e] = wf[(e >> 5) * 128 + 32 * dq + (e & 31)]; }
    __syncthreads();
    bf16_t* WfT = (bf16_t*)(F.ws + ((l & 1) ? WS_WFT2 : WS_WFT));
    for (int it = F.tid; it < 32 * 64; it += 512) {
        const int d = 32 * dq + (it >> 6), c0 = (it & 63) * 2; float s0 = 0.f, s1 = 0.f;
#pragma unroll 4
        for (int dp = 0; dp < 128; ++dp) { const float w = wl[dp * 32 + (it >> 6)]; s0 += tr[(dp * c0) & 127] * w; s1 += tr[(dp * (c0 + 1)) & 127] * w; }
        bf16_t* row = WfT + (size_t)((g * 128 + d) * 2 + cs) * 512;
#pragma unroll
        for (int gp = 0; gp < 4; ++gp) *(unsigned*)(row + gp * 128 + c0) = (gp == g) ? pk2(s0, s1) : 0u;
    }
    __syncthreads();
}
__device__ __forceinline__ void setup_layer(Frame& F, int l, int ub, int nb) {
    const int par = l & 1, rb = F.bid - ub;
    __syncthreads();
    { if (rb < 128) s5_setup_unit(F, l, rb);
      else if (rb < 160) fourier_setup_unit(F, l, rb - 128); }
    LAS float* scr = (LAS float*)(F.lds + F.wave * 16384);
    const int gw = rb * 8 + F.wave, NGW = nb * 8;
    const float* win = F.in[F.zi + I_WIN] + (size_t)l * DM * IN_COLS;
    bf16_t* Wi = (bf16_t*)(F.ws + (par ? WS_WIN2 : WS_WIN)); bf16_t* Ws = (bf16_t*)(F.ws + (par ? WS_WSW2 : WS_WSW));
    constexpr int I_A = 32 * (N1A / 32), I_V = 32 * 16, I_S = 32 * 16, I_UP = 4 * 8 * 64, I_O = 32 * 64, I_G = 8 * 16;
    constexpr int NIT = I_A + I_V + I_S + I_UP + I_O + I_G;
    for (int it = gw; it < NIT; it += NGW) {
        int r = it;
        if (r < I_A) { const int kb = r / (N1A / 32), nb2 = r % (N1A / 32); transpose_item(win, IN_COLS, win_src_col(nb2 * 32), kb * 64, Wi, DM, nb2 * 32, scr, F.lane); continue; } r -= I_A;
        if (r < I_V) { const int kb = r / 16, nb2 = r % 16; transpose_item(win, IN_COLS, OFF_C_V + nb2 * 32, kb * 64, Ws, DM, nb2 * 32, scr, F.lane); continue; } r -= I_V;
        if (r < I_S) { const int kb = r / 16, nb2 = r % 16; transpose_item(win, IN_COLS, OFF_A_UV + 512 + nb2 * 32, kb * 64, Ws, DM, 512 + nb2 * 32, scr, F.lane); continue; } r -= I_S;
        if (r < I_UP) { const int i = r / 512, rr = r % 512, kb = rr / 64, nb2 = rr % 64;
            transpose_item(F.in[F.zi + I_WUP] + ((size_t)l * 4 + i) * 512 * DM, DM, nb2 * 32, kb * 64, (bf16_t*)(F.ws + WS_WUP + (size_t)par * WUP_STRIDE) + (size_t)i * DM * 512, 512, nb2 * 32, scr, F.lane); continue; } r -= I_UP;
        if (r < I_O) { const int kb = r / 64, nb2 = r % 64; transpose_item(F.in[F.zi + I_WO] + (size_t)l * DM * DM, DM, nb2 * 32, kb * 64, (bf16_t*)(F.ws + WS_WO + (size_t)par * WO_STRIDE), DM, nb2 * 32, scr, F.lane); continue; } r -= I_O;
        { const int kb = r / 16, nb2 = r % 16; transpose_item(F.in[F.zi + I_WGLU] + (size_t)l * 512 * 512, 512, nb2 * 32, kb * 64, (bf16_t*)(F.ws + WS_WGLU + (size_t)par * WGLU_STRIDE), 512, nb2 * 32, scr, F.lane); }
    }
    const int gt = rb * 512 + F.tid, NGT = nb * 512;
    const float* bin = F.in[F.zi + I_BIN] + (size_t)l * IN_COLS;
    float* b1a = (float*)(F.ws + WS_BIAS1A + (size_t)par * SMALL_STRIDE); float* b1b = (float*)(F.ws + WS_BIAS1B + (size_t)par * SMALL_STRIDE);
    for (int j = gt; j < N1A; j += NGT) b1a[j] = bin[win_src_col(j)];
    for (int j = gt; j < 512; j += NGT) { b1b[j] = bin[OFF_C_V + j]; b1b[512 + j] = bin[OFF_A_UV + 512 + j]; }
    const float* wsg = F.in[F.zi + I_WSGU] + (size_t)l * 4 * 128 * 128; bf16_t* wsb = (bf16_t*)(F.ws + WS_WSGU + (size_t)par * SMALL_STRIDE);
    for (int j = gt; j < 4 * 128 * 64; j += NGT) *(unsigned*)(wsb + 2 * j) = pk2(wsg[2 * j], wsg[2 * j + 1]);
}
__device__ __forceinline__ void prologue_a(Frame& F) {
    const int gw = F.bid * 8 + F.wave, NGW = F.G * 8;
    LAS float* sl = (LAS float*)(F.lds + F.wave * 16384);
    float* part = (float*)(F.ws + WS_ADAP);
    for (int it = gw; it < 4 * 24 * 16; it += NGW) {
        const int l = it / 384, r = it % 384, cg = r / 16, kp = r % 16;
        int ln = F.lane; asm volatile("" : "+v"(ln));
        { const float* cp = F.in[F.zi + I_C] + kp * 128 + ln; const float* xp = F.in[F.zi + I_CCTX] + kp * 128 + ln;
          float cv[34];
#pragma unroll
          for (int i = 0; i < 34; ++i) cv[i] = i < 32 ? cp[(i >> 1) * DM + (i & 1) * 64] : xp[(i & 1) * 64];
#pragma unroll
          for (int i = 0; i < 34; ++i) sl[ln + 64 * i] = silu_f(cv[i]); }
        LDS_WAIT(); asm volatile("" ::: "memory");
        const char* wb = (const char*)(F.in[F.zi + I_WADA] + (size_t)l * DM * 6144 + (size_t)(kp * 128) * 6144 + cg * 256) + ln * 16;
        f32x4 a[17];
#pragma unroll
        for (int q = 0; q < 17; ++q) a[q] = (f32x4){0.f, 0.f, 0.f, 0.f};
#pragma unroll 1
        for (int k0 = 0; k0 < 128; k0 += 8) {
            f32x4 wv[8];
#pragma unroll
            for (int j = 0; j < 8; ++j) wv[j] = *(const f32x4*)(wb + (size_t)(k0 + j) * (6144 * 4));
#pragma unroll
            for (int j4 = 0; j4 < 8; j4 += 4) {
#pragma unroll
                for (int q = 0; q < 17; ++q) { const f32x4 sv = *(const LAS f32x4*)(sl + q * 128 + k0 + j4);
                    a[q] += sv[0] * wv[j4]; a[q] += sv[1] * wv[j4 + 1]; a[q] += sv[2] * wv[j4 + 2]; a[q] += sv[3] * wv[j4 + 3]; }
                asm volatile("" ::: "memory");
            }
        }
#pragma unroll
        for (int q = 0; q < 17; ++q) *(f32x4*)(part + (((size_t)l * 16 + kp) * 17 + q) * 6144 + cg * 256 + ln * 4) = a[q];
        LDS_WAIT(); asm volatile("" ::: "memory");
    }
    bf16_t* dft = (bf16_t*)(F.ws + WS_DFT); bf16_t* dft2 = (bf16_t*)(F.ws + WS_DFT256);
    for (int n = gw; n < 2048 + 256; n += NGW) {
        if (n < 2048) { bf16_t* row = dft + (size_t)n * 4096;
            for (int k2 = F.lane; k2 < 2048; k2 += 64) { const int k = 2 * k2; float v[2];
#pragma unroll
                for (int e = 0; e < 2; ++e) { const int kk = k + e, np = kk & 2047; const float rev = (float)((n * np) & 2047) * (1.0f / 2048.0f);
                    v[e] = (kk < 2048 ? hw_cos_rev(rev) : -hw_sin_rev(rev)) * 0.022097086912079608f; }
                *(unsigned*)(row + k) = pk2(v[0], v[1]); }
        } else { const int nn = n - 2048; bf16_t* row = dft2 + (size_t)nn * 512;
            for (int k2 = F.lane; k2 < 256; k2 += 64) { const int k = 2 * k2; float v[2];
#pragma unroll
                for (int e = 0; e < 2; ++e) { const int kk = k + e, np = kk & 255; const float rev = (float)((nn * np) & 255) * (1.0f / 256.0f);
                    v[e] = (kk < 256 ? hw_cos_rev(rev) : -hw_sin_rev(rev)) * 0.0625f; }
                *(unsigned*)(row + k) = pk2(v[0], v[1]); }
        }
    }
}
__device__ __forceinline__ void ada_reduce(Frame& F) {
    const int gt = F.bid * 512 + F.tid, NGT = F.G * 512;
    const float* part = (const float*)(F.ws + WS_ADAP); float* ada = (float*)(F.ws + WS_ADA);
    for (int e = gt; e < 4 * 17 * 6144; e += NGT) {
        const int l = e / (17 * 6144), r = e % (17 * 6144), j = r % 6144;
        float s = F.in[F.zi + I_BADA][l * 6144 + j];
#pragma unroll
        for (int kp = 0; kp < 16; ++kp) s += part[((size_t)l * 16 + kp) * 17 * 6144 + r];
        ada[e] = s;
    }
}

__device__ __forceinline__ void ln_phase(Frame& F, int mode, const float* xin, const float* cin, float* xr, float* cr, const float* lng, const float* lnb, const float* adaN, int nrows) {
    const int gw = F.bid * 8 + F.wave, NGW = F.G * 8;
    bf16_t* H = (bf16_t*)(F.ws + WS_H);
    for (int row = gw; row < nrows; row += NGW) {
        const bool isx = row < MX; const int bidx = isx ? (row >> 11) : 16;
        f32x4 v[8];
        if (mode == 0) { const f32x4* s = (const f32x4*)((isx ? xin + (size_t)row * DM : cin + (size_t)(row - MX) * DM)) + F.lane;
#pragma unroll
            for (int j = 0; j < 8; ++j) v[j] = s[64 * j];
        } else {
            f32x4* s = (f32x4*)((isx ? xr + (size_t)row * DM : cr + (size_t)(row - MX) * DM)) + F.lane;
            float sm = 0.f;
#pragma unroll
            for (int j = 0; j < 8; ++j) { v[j] = s[64 * j]; sm += (v[j][0] + v[j][1]) + (v[j][2] + v[j][3]); }
            const float mean = wave_sum(sm, F.lane) * (1.0f / DM); float q = 0.f;
#pragma unroll
            for (int j = 0; j < 8; ++j) { v[j] = v[j] - mean; q += (v[j][0] * v[j][0] + v[j][1] * v[j][1]) + (v[j][2] * v[j][2] + v[j][3] * v[j][3]); }
            const float rstd = 1.0f / sqrtf(wave_sum(q, F.lane) * (1.0f / DM) + LN_EPS);
#pragma unroll
            for (int j = 0; j < 8; ++j) { const f32x4 gg = *((const f32x4*)lng + F.lane + 64 * j), bb = *((const f32x4*)lnb + F.lane + 64 * j); v[j] = v[j] * rstd * gg + bb; s[64 * j] = v[j]; }
        }
        if (adaN) {
            float sm = 0.f;
#pragma unroll
            for (int j = 0; j < 8; ++j) sm += (v[j][0] + v[j][1]) + (v[j][2] + v[j][3]);
            const float mean = wave_sum(sm, F.lane) * (1.0f / DM); float q = 0.f;
#pragma unroll
            for (int j = 0; j < 8; ++j) { v[j] = v[j] - mean; q += (v[j][0] * v[j][0] + v[j][1] * v[j][1]) + (v[j][2] * v[j][2] + v[j][3] * v[j][3]); }
            const float rstd = 1.0f / sqrtf(wave_sum(q, F.lane) * (1.0f / DM) + LN_EPS);
            const f32x4* sh = (const f32x4*)(adaN + (size_t)bidx * 6144) + F.lane; const f32x4* sc = (const f32x4*)(adaN + (size_t)bidx * 6144 + 2048) + F.lane;
            u32x2* o = (u32x2*)(H + (size_t)row * DM) + F.lane;
#pragma unroll
            for (int j = 0; j < 8; ++j) { const f32x4 a = sh[64 * j], b = sc[64 * j]; const f32x4 h = v[j] * rstd * (b + 1.0f) + a; u32x2 w; w.x = pk2(h[0], h[1]); w.y = pk2(h[2], h[3]); o[64 * j] = w; }
        }
    }
}

__device__ __forceinline__ void ln2_phase(Frame& F, float* xr, float* cr, const float* lng, const float* lnb, const float* adaN, int nrows) {
    const int gw = F.bid * 8 + F.wave, NGW = F.G * 8, lane = F.lane;
    bf16_t* H = (bf16_t*)(F.ws + WS_H); float* RS = (float*)(F.ws + WS_RS);
    const int RW = nrows / NGW, row0 = gw * RW;
    f32x4 gg[8], bb[8], sh[8], sc[8];
#pragma unroll
    for (int j = 0; j < 8; ++j) { gg[j] = *((const f32x4*)lng + lane + 64 * j); bb[j] = *((const f32x4*)lnb + lane + 64 * j); sh[j] = gg[j]; sc[j] = gg[j]; }
    int curb = -1;
    f32x4 vn[8];
    { const f32x4* s0 = (const f32x4*)((row0 < MX ? xr + (size_t)row0 * DM : cr + (size_t)(row0 - MX) * DM)) + lane;
#pragma unroll
      for (int j = 0; j < 8; ++j) vn[j] = s0[64 * j]; }
    for (int i = 0; i < RW; ++i) {
        const int row = row0 + i;
        const bool isx = row < MX; const int bidx = isx ? (row >> 11) : 16;
        f32x4* s = (f32x4*)((isx ? xr + (size_t)row * DM : cr + (size_t)(row - MX) * DM)) + lane;
        f32x4 v[8]; float sm = 0.f;
#pragma unroll
        for (int j = 0; j < 8; ++j) { v[j] = vn[j]; sm += (v[j][0] + v[j][1]) + (v[j][2] + v[j][3]); }
        if (i + 1 < RW) { const int rn = row + 1;
            const f32x4* sn = (const f32x4*)((rn < MX ? xr + (size_t)rn * DM : cr + (size_t)(rn - MX) * DM)) + lane;
#pragma unroll
            for (int j = 0; j < 8; ++j) vn[j] = sn[64 * j]; }
        if (adaN != nullptr && bidx != curb) { curb = bidx;
            const f32x4* shp = (const f32x4*)(adaN + (size_t)bidx * 6144) + lane; const f32x4* scp = (const f32x4*)(adaN + (size_t)bidx * 6144 + 2048) + lane;
#pragma unroll
            for (int j = 0; j < 8; ++j) { sh[j] = shp[64 * j]; sc[j] = scp[64 * j] + 1.0f; } }
        const float mu = wave_sum(sm, lane) * (1.0f / DM); float q = 0.f;
#pragma unroll
        for (int j = 0; j < 8; ++j) { v[j] = v[j] - mu; q += (v[j][0] * v[j][0] + v[j][1] * v[j][1]) + (v[j][2] * v[j][2] + v[j][3] * v[j][3]); }
        const float ar = 1.0f / sqrtf(wave_sum(q, lane) * (1.0f / DM) + LN_EPS);
#pragma unroll
        for (int j = 0; j < 8; ++j) v[j] = v[j] * ar * gg[j] + bb[j];
        if (adaN == nullptr) {
#pragma unroll
            for (int j = 0; j < 8; ++j) s[64 * j] = v[j];
        } else {
            if (lane == 0) *(f32x2*)(RS + (size_t)row * 2) = (f32x2){mu, ar};
            float sm2 = 0.f;
#pragma unroll
            for (int j = 0; j < 8; ++j) sm2 += (v[j][0] + v[j][1]) + (v[j][2] + v[j][3]);
            const float mean2 = wave_sum(sm2, lane) * (1.0f / DM); float q2 = 0.f;
#pragma unroll
            for (int j = 0; j < 8; ++j) { v[j] = v[j] - mean2; q2 += (v[j][0] * v[j][0] + v[j][1] * v[j][1]) + (v[j][2] * v[j][2] + v[j][3] * v[j][3]); }
            const float rstd2 = 1.0f / sqrtf(wave_sum(q2, lane) * (1.0f / DM) + LN_EPS);
            u32x2* o = (u32x2*)(H + (size_t)row * DM) + lane;
#pragma unroll
            for (int j = 0; j < 8; ++j) { const f32x4 h = v[j] * rstd2 * sc[j] + sh[j]; u32x2 w; w.x = pk2(h[0], h[1]); w.y = pk2(h[2], h[3]); o[64 * j] = w; }
        }
    }
}

__device__ __forceinline__ void s5_scan_phase(Frame& F, int par) {
    const int gw = F.bid * 8 + F.wave, NGW = F.G * 8;
    const float* E = (const float*)(F.ws + WS_E); bf16_t* Xs = (bf16_t*)(F.ws + WS_XS); const float* AT = (const float*)(F.ws + WS_AT + (size_t)par * AT_STRIDE);
    for (int it = gw; it < NBATCH * 32 * 2; it += NGW) {
        const int b = it >> 6, g = (it >> 1) & 31, d = it & 1, p = F.lane;
        const float ar = AT[((g * 2 + d) * 64 + p) * 2], ai = AT[((g * 2 + d) * 64 + p) * 2 + 1];
        float hr = 0.f, hi = 0.f;
        for (int c0 = 0; c0 < 72; c0 += 8) {
            float er[8], ei[8]; int rows[8];
#pragma unroll
            for (int q = 0; q < 8; ++q) { const int c = c0 + q;
                int row; if (c < 8) row = 1024 + b * 8 + (d == 0 ? c : 7 - c); else row = b * 64 + (d == 0 ? (c - 8) : 63 - (c - 8));
                rows[q] = row; const float* e = E + ((size_t)g * XS_ROWS + row) * 256 + d * 128 + p; er[q] = e[0]; ei[q] = e[64]; }
#pragma unroll
            for (int q = 0; q < 8; ++q) {
                bf16_t* xs = Xs + ((size_t)g * XS_ROWS + rows[q]) * XS_K + 512 + d * 128 + p;
                xs[0] = (bf16_t)(pk2(hr, 0.f) & 0xffffu); xs[64] = (bf16_t)(pk2(hi, 0.f) & 0xffffu);
                const float nr = ar * hr - ai * hi + er[q], ni = ar * hi + ai * hr + ei[q]; hr = nr; hi = ni;
            }
        }
    }
}

__device__ __forceinline__ void sgu_phase(Frame& F, int l, int u_first, int u_end) {
    const bf16_t* vT = (const bf16_t*)(F.ws + WS_VTS); const bf16_t* Z = (const bf16_t*)(F.ws + WS_Z); bf16_t* Y = (bf16_t*)(F.ws + WS_Y);
    const bf16_t* wsb = (const bf16_t*)(F.ws + WS_WSGU + (size_t)(l & 1) * SMALL_STRIDE); const float* bsg = F.in[F.zi + I_BSGU] + (size_t)l * 4 * 128;
    LAS float* part = (LAS float*)(F.lds);
    LAS float* stat = (LAS float*)(F.lds + 8192);
    LAS unsigned char* tile = F.lds + 16384;
    const int lane = F.lane, w = F.wave, tid = F.tid;
    for (int uu = u_first; uu < u_end; uu += F.G) {
        const int ck = uu >> 2, g = uu & 3;
        const int tok0 = ck < 256 ? ck * 128 : MX + (ck - 256) * 128;
        u32x4 tv[4];
#pragma unroll
        for (int j = 0; j < 4; ++j) { const int e = tid + 512 * j, c = e >> 4, ch16 = e & 15; tv[j] = *(const u32x4*)(vT + (size_t)(g * 128 + c) * MT + tok0 + 8 * ch16); }
        {
          float sa[8], qa[8];
#pragma unroll
          for (int e = 0; e < 8; ++e) { sa[e] = 0.f; qa[e] = 0.f; }
          const bf16_t* src = vT + (size_t)(64 * w + (lane >> 4)) * MT + tok0 + 8 * (lane & 15);
#pragma unroll
          for (int i = 0; i < 16; ++i) { const u32x4 x = *(const u32x4*)(src + (size_t)(4 * i) * MT);
              const float f0 = bflo(x.x), f1 = bfhi(x.x), f2 = bflo(x.y), f3 = bfhi(x.y), f4 = bflo(x.z), f5 = bfhi(x.z), f6 = bflo(x.w), f7 = bfhi(x.w);
              sa[0] += f0; qa[0] += f0 * f0; sa[1] += f1; qa[1] += f1 * f1; sa[2] += f2; qa[2] += f2 * f2; sa[3] += f3; qa[3] += f3 * f3;
              sa[4] += f4; qa[4] += f4 * f4; sa[5] += f5; qa[5] += f5 * f5; sa[6] += f6; qa[6] += f6 * f6; sa[7] += f7; qa[7] += f7 * f7; }
#pragma unroll
          for (int e = 0; e < 8; ++e) { sa[e] += shx(sa[e], 16, lane); qa[e] += shx(qa[e], 16, lane); sa[e] += shx(sa[e], 32, lane); qa[e] += shx(qa[e], 32, lane); }
          if (lane < 16) {
#pragma unroll
              for (int e = 0; e < 8; ++e) { part[(w * 128 + 8 * lane + e) * 2] = sa[e]; part[(w * 128 + 8 * lane + e) * 2 + 1] = qa[e]; } } }
#pragma unroll
        for (int j = 0; j < 4; ++j) { const int e = tid + 512 * j, c = e >> 4, ch16 = e & 15; *(LAS u32x4*)(tile + c * 272 + ch16 * 16) = tv[j]; }
        __syncthreads();
        if (tid < 128) { float s = 0.f, q = 0.f;
#pragma unroll
            for (int ww = 0; ww < 8; ++ww) { s += part[(ww * 128 + tid) * 2]; q += part[(ww * 128 + tid) * 2 + 1]; }
            const float mean = s * (1.0f / 512.0f); float var = q * (1.0f / 512.0f) - mean * mean; var = var < 0.f ? 0.f : var;
            stat[tid * 2] = mean; stat[tid * 2 + 1] = 1.0f / sqrtf(var + LN_EPS); }
        __syncthreads();
        const int p = 16 * w + (lane & 15), kq = lane >> 4;
        {
            bf16x8 bfr[4]; float corr = 0.f;
#pragma unroll
            for (int ks = 0; ks < 4; ++ks) {
                const u32x4 wv = *(const u32x4*)(wsb + ((size_t)g * 128 + p) * 128 + 32 * ks + 8 * kq);
                const int q0 = 32 * ks + 8 * kq; float a[8];
                a[0] = bflo(wv.x); a[1] = bfhi(wv.x); a[2] = bflo(wv.y); a[3] = bfhi(wv.y); a[4] = bflo(wv.z); a[5] = bfhi(wv.z); a[6] = bflo(wv.w); a[7] = bfhi(wv.w);
                u32x4 o; unsigned pk[4];
#pragma unroll
                for (int j = 0; j < 4; ++j) { const float r0 = stat[(q0 + 2 * j) * 2 + 1], r1 = stat[(q0 + 2 * j + 1) * 2 + 1]; pk[j] = pk2(a[2 * j] * r0, a[2 * j + 1] * r1);
                    corr += bflo(pk[j]) * stat[(q0 + 2 * j) * 2] + bfhi(pk[j]) * stat[(q0 + 2 * j + 1) * 2]; }
                o.x = pk[0]; o.y = pk[1]; o.z = pk[2]; o.w = pk[3];
                bfr[ks] = __builtin_bit_cast(bf16x8, o);
            }
            corr += shx(corr, 16, lane); corr += shx(corr, 32, lane);
            const float addp = bsg[g * 128 + p] - corr;
            const size_t tok = (size_t)(tok0 + p);
            u32x2 ua[8], ga[8];
#pragma unroll
            for (int ct = 0; ct < 8; ++ct) { const int ch = g * 128 + ct * 16 + 4 * kq; ua[ct] = *(const u32x2*)(Z + tok * LDZ + ZC_AU + ch); ga[ct] = *(const u32x2*)(Z + tok * LDZ + ZC_GATE + ch); }
            f32x4 acc[8];
#pragma unroll
            for (int ct = 0; ct < 8; ++ct) {
                acc[ct] = (f32x4){0.f, 0.f, 0.f, 0.f};
#pragma unroll
                for (int ks = 0; ks < 4; ++ks) {
                    const bf16x8 af = *(const LAS bf16x8*)(tile + (ct * 16 + (lane & 15)) * 272 + (32 * ks + 8 * kq) * 2);
                    acc[ct] = __builtin_amdgcn_mfma_f32_16x16x32_bf16(af, bfr[ks], acc[ct], 0, 0, 0);
                }
            }
#pragma unroll
            for (int ct = 0; ct < 8; ++ct) {
                const int ch = g * 128 + ct * 16 + 4 * kq;
                const u32x2 uu2 = ua[ct], gg = ga[ct];
                u32x2 o;
                o.x = pk2((acc[ct][0] + addp) * bflo(uu2.x) * bflo(gg.x), (acc[ct][1] + addp) * bfhi(uu2.x) * bfhi(gg.x));
                o.y = pk2((acc[ct][2] + addp) * bflo(uu2.y) * bflo(gg.y), (acc[ct][3] + addp) * bfhi(uu2.y) * bfhi(gg.y));
                *(u32x2*)(Y + tok * DM + ch) = o;
            }
        }
        __syncthreads();
    }
}

constexpr int ATT_KROW = 272, ATT_VROW = 80, ATT_KBUF = 32 * ATT_KROW, ATT_VBUF = 128 * ATT_VROW;
constexpr int ATT_VOFF = 2 * ATT_KBUF, ATT_RPB = 38912;
__device__ __forceinline__ void att_block_unit(Frame& F, int u) {
    const bf16_t* Z = (const bf16_t*)(F.ws + WS_Z); const bf16_t* Vt = (const bf16_t*)(F.ws + WS_VT); bf16_t* Y = (bf16_t*)(F.ws + WS_Y);
    const LAS float* rpb_s = (const LAS float*)(F.lds + ATT_RPB);
    const int lane = F.lane, l31 = lane & 31, hh = lane >> 5, w = F.wave, tid = F.tid;
    const bool band = u < 512;
    int b, h, r0;
    if (band) { b = u >> 5; h = (u >> 3) & 3; r0 = (u & 7) * 4; } else { const int v = u - 512; b = v >> 2; h = v & 3; r0 = 0; }
    const int half = w & 1, r = r0 + (w >> 1);
    const int qtok0 = band ? b * SEQ + r * 64 + half * 32 : MX + b * CTXL + w * 32;
    const int rs = r < 4 ? 0 : (r > 28 ? 24 : r - 4);
    const int rlo = r0 < 4 ? 0 : (r0 > 28 ? 24 : r0 - 4);
    const int rhi = ((r0 + 3) < 4 ? 0 : ((r0 + 3) > 28 ? 24 : r0 + 3 - 4)) + 7;
    const int npair = (rhi - rlo + 2) >> 1;
    const int nsteps = band ? 8 + 4 * npair : 8;
    const int wq = half * 32 + l31;
    const int cst = wq < 8 ? 0 : (wq > 56 ? 48 : wq - 8);
    const unsigned long long wmask = 0xFFFFull << cst;
    const int ctxtok = MX + b * CTXL, xtok = b * SEQ;
    bf16x8 qf[8];
    { const bf16_t* qp = Z + (size_t)(qtok0 + l31) * LDZ + ZC_Q + h * 128 + 8 * hh;
#pragma unroll
      for (int s = 0; s < 8; ++s) qf[s] = *(const bf16x8*)(qp + 16 * s); }
    f32x16 O[4];
#pragma unroll
    for (int dt = 0; dt < 4; ++dt)
#pragma unroll
        for (int i = 0; i < 16; ++i) O[dt][i] = 0.f;
    float mrun = -3.0e38f, lrun = 0.f;
    const int kkey = tid >> 4, kch = tid & 15, vd = tid >> 2, vpc = tid & 3;
    const bf16_t* kgb = Z + ZC_K + h * 128 + 8 * kch;
    const bf16_t* vgb = Vt + (size_t)(h * 128 + vd) * MT;
    LAS unsigned char* kst = F.lds + kkey * ATT_KROW + kch * 16;
    LAS unsigned char* vst = F.lds + ATT_VOFF + vd * ATT_VROW + (vpc >> 1) * 32 + (vpc & 1) * 8;
    const LAS unsigned char* krd = F.lds + l31 * ATT_KROW + 16 * hh;
    const LAS unsigned char* vrd = F.lds + ATT_VOFF + l31 * ATT_VROW + 16 * hh;
    u32x4 kreg, vreg, kreg2, vreg2;
#define ATT_LOAD(t) do { int kt_, vt_; \
        if ((t) < 8) { kt_ = ctxtok + 32 * (t) + kkey; vt_ = ctxtok + 32 * (t) + 8 * vpc; } \
        else { const int tb_ = (t) - 8, R0_ = rlo + 2 * (tb_ >> 2), cb_ = tb_ & 3; kt_ = xtok + (R0_ + (kkey >> 4)) * 64 + 16 * cb_ + (kkey & 15); vt_ = xtok + (R0_ + (vpc >> 1)) * 64 + 16 * cb_ + 8 * (vpc & 1); } \
        kreg = *(const u32x4*)(kgb + (size_t)kt_ * LDZ); vreg = *(const u32x4*)(vgb + vt_); } while (0)
#define ATT_LOADR(t, KR, VR) do { int kt_, vt_; \
        if ((t) < 8) { kt_ = ctxtok + 32 * (t) + kkey; vt_ = ctxtok + 32 * (t) + 8 * vpc; } \
        else { const int tb_ = (t) - 8, R0_ = rlo + 2 * (tb_ >> 2), cb_ = tb_ & 3; kt_ = xtok + (R0_ + (kkey >> 4)) * 64 + 16 * cb_ + (kkey & 15); vt_ = xtok + (R0_ + (vpc >> 1)) * 64 + 16 * cb_ + 8 * (vpc & 1); } \
        KR = *(const u32x4*)(kgb + (size_t)kt_ * LDZ); VR = *(const u32x4*)(vgb + vt_); } while (0)
#define ATT_STORER(nx, KR, VR) do { *(LAS u32x4*)(kst + (nx) * ATT_KBUF) = KR; LAS u32x2* vs_ = (LAS u32x2*)(vst + (nx) * ATT_VBUF); vs_[0] = (u32x2){VR.x, VR.y}; vs_[2] = (u32x2){VR.z, VR.w}; } while (0)
    ATT_LOADR(0, kreg, vreg);
    ATT_STORER(0, kreg, vreg);
    ATT_LOADR(1, kreg2, vreg2);
    __syncthreads();
    for (int t0 = 0; t0 < nsteps; t0 += 2) {
        {
            const int t = t0;
            if (t + 2 < nsteps) ATT_LOADR(t + 2, kreg, vreg);
        const bool isb = t >= 8;
        const int tb = t - 8, R0 = rlo + 2 * (tb >> 2), cb = tb & 3;
        const bool part = !isb || ((cb >= half) && (cb <= half + 2) && (R0 + 1 >= rs) && (R0 <= rs + 7));
        if (part) {
            const LAS unsigned char* kb = krd + 0 * ATT_KBUF; const LAS unsigned char* vb = vrd + 0 * ATT_VBUF;
            f32x16 S, S2; bf16x8 kf[8];
#pragma unroll
            for (int i = 0; i < 16; ++i) { S[i] = 0.f; S2[i] = 0.f; }
#pragma unroll
            for (int s = 0; s < 8; ++s) kf[s] = *(const LAS bf16x8*)(kb + 32 * s);
#pragma unroll
            for (int s = 0; s < 8; s += 2) {
                S = __builtin_amdgcn_mfma_f32_32x32x16_bf16(kf[s], qf[s], S, 0, 0, 0);
                S2 = __builtin_amdgcn_mfma_f32_32x32x16_bf16(kf[s + 1], qf[s + 1], S2, 0, 0, 0); }
            bf16x8 vf[2][4];
#pragma unroll
            for (int s2 = 0; s2 < 2; ++s2)
#pragma unroll
                for (int dt = 0; dt < 4; ++dt) vf[s2][dt] = *(const LAS bf16x8*)(vb + (32 * dt) * ATT_VROW + 32 * s2);
#pragma unroll
            for (int i = 0; i < 16; ++i) S[i] += S2[i];
            if (isb) {
                const int sh = 16 * cb + 4 * hh;
                const unsigned ml = (unsigned)(wmask >> sh);
                const unsigned m0 = ((R0 >= rs) && (R0 <= rs + 7)) ? ml : 0u, m1 = ((R0 + 1 >= rs) && (R0 + 1 <= rs + 7)) ? ml : 0u;
                const LAS float* rp = rpb_s + h * 465 + (R0 - r + 7) * 31 + 15 + (sh - wq);
#pragma unroll
                for (int i = 0; i < 16; ++i) {
                    const int c = (i & 3) + 8 * ((i >> 2) & 1);
                    const unsigned mm = (i >> 3) ? m1 : m0;
                    const float rv = rp[(i >> 3) * 31 + c];
                    S[i] = ((mm >> c) & 1u) ? S[i] + rv : -1.0e30f;
                }
            }
            float tmax = S[0];
#pragma unroll
            for (int i = 1; i < 16; ++i) tmax = fmaxf(tmax, S[i]);
            tmax = fmaxf(tmax, shx(tmax, 32, lane));
            if (__any(tmax > mrun + 8.0f)) {
                const float mnew = fmaxf(mrun, tmax);
                const float alpha = __builtin_amdgcn_exp2f(mrun - mnew);
                lrun *= alpha; mrun = mnew;
#pragma unroll
                for (int dt = 0; dt < 4; ++dt)
#pragma unroll
                    for (int i = 0; i < 16; ++i) O[dt][i] *= alpha;
            }
            float ls = 0.f;
#pragma unroll
            for (int i = 0; i < 16; ++i) { S[i] = __builtin_amdgcn_exp2f(S[i] - mrun); ls += S[i]; }
            lrun += ls;
#pragma unroll
            for (int s2 = 0; s2 < 2; ++s2) {
                u32x4 pp; pp.x = pk2(S[8 * s2 + 0], S[8 * s2 + 1]); pp.y = pk2(S[8 * s2 + 2], S[8 * s2 + 3]); pp.z = pk2(S[8 * s2 + 4], S[8 * s2 + 5]); pp.w = pk2(S[8 * s2 + 6], S[8 * s2 + 7]);
                const bf16x8 pf = __builtin_bit_cast(bf16x8, pp);
#pragma unroll
                for (int dt = 0; dt < 4; ++dt) {
                    O[dt] = __builtin_amdgcn_mfma_f32_32x32x16_bf16(vf[s2][dt], pf, O[dt], 0, 0, 0);
                }
            }
        }
            ATT_STORER(1, kreg2, vreg2);
            __syncthreads();
        }
        {
            const int t = t0 + 1;
            if (t + 2 < nsteps) ATT_LOADR(t + 2, kreg2, vreg2);
        const bool isb = t >= 8;
        const int tb = t - 8, R0 = rlo + 2 * (tb >> 2), cb = tb & 3;
        const bool part = !isb || ((cb >= half) && (cb <= half + 2) && (R0 + 1 >= rs) && (R0 <= rs + 7));
        if (part) {
            const LAS unsigned char* kb = krd + 1 * ATT_KBUF; const LAS unsigned char* vb = vrd + 1 * ATT_VBUF;
            f32x16 S, S2; bf16x8 kf[8];
#pragma unroll
            for (int i = 0; i < 16; ++i) { S[i] = 0.f; S2[i] = 0.f; }
#pragma unroll
            for (int s = 0; s < 8; ++s) kf[s] = *(const LAS bf16x8*)(kb + 32 * s);
#pragma unroll
            for (int s = 0; s < 8; s += 2) {
                S = __builtin_amdgcn_mfma_f32_32x32x16_bf16(kf[s], qf[s], S, 0, 0, 0);
                S2 = __builtin_amdgcn_mfma_f32_32x32x16_bf16(kf[s + 1], qf[s + 1], S2, 0, 0, 0); }
            bf16x8 vf[2][4];
#pragma unroll
            for (int s2 = 0; s2 < 2; ++s2)
#pragma unroll
                for (int dt = 0; dt < 4; ++dt) vf[s2][dt] = *(const LAS bf16x8*)(vb + (32 * dt) * ATT_VROW + 32 * s2);
#pragma unroll
            for (int i = 0; i < 16; ++i) S[i] += S2[i];
            if (isb) {
                const int sh = 16 * cb + 4 * hh;
                const unsigned ml = (unsigned)(wmask >> sh);
                const unsigned m0 = ((R0 >= rs) && (R0 <= rs + 7)) ? ml : 0u, m1 = ((R0 + 1 >= rs) && (R0 + 1 <= rs + 7)) ? ml : 0u;
                const LAS float* rp = rpb_s + h * 465 + (R0 - r + 7) * 31 + 15 + (sh - wq);
#pragma unroll
                for (int i = 0; i < 16; ++i) {
                    const int c = (i & 3) + 8 * ((i >> 2) & 1);
                    const unsigned mm = (i >> 3) ? m1 : m0;
                    const float rv = rp[(i >> 3) * 31 + c];
                    S[i] = ((mm >> c) & 1u) ? S[i] + rv : -1.0e30f;
                }
            }
            float tmax = S[0];
#pragma unroll
            for (int i = 1; i < 16; ++i) tmax = fmaxf(tmax, S[i]);
            tmax = fmaxf(tmax, shx(tmax, 32, lane));
            if (__any(tmax > mrun + 8.0f)) {
                const float mnew = fmaxf(mrun, tmax);
                const float alpha = __builtin_amdgcn_exp2f(mrun - mnew);
                lrun *= alpha; mrun = mnew;
#pragma unroll
                for (int dt = 0; dt < 4; ++dt)
#pragma unroll
                    for (int i = 0; i < 16; ++i) O[dt][i] *= alpha;
            }
            float ls = 0.f;
#pragma unroll
            for (int i = 0; i < 16; ++i) { S[i] = __builtin_amdgcn_exp2f(S[i] - mrun); ls += S[i]; }
            lrun += ls;
#pragma unroll
            for (int s2 = 0; s2 < 2; ++s2) {
                u32x4 pp; pp.x = pk2(S[8 * s2 + 0], S[8 * s2 + 1]); pp.y = pk2(S[8 * s2 + 2], S[8 * s2 + 3]); pp.z = pk2(S[8 * s2 + 4], S[8 * s2 + 5]); pp.w = pk2(S[8 * s2 + 6], S[8 * s2 + 7]);
                const bf16x8 pf = __builtin_bit_cast(bf16x8, pp);
#pragma unroll
                for (int dt = 0; dt < 4; ++dt) {
                    O[dt] = __builtin_amdgcn_mfma_f32_32x32x16_bf16(vf[s2][dt], pf, O[dt], 0, 0, 0);
                }
            }
        }
            if (t + 1 < nsteps) ATT_STORER(0, kreg, vreg);
            __syncthreads();
        }
    }
#undef ATT_LOADR
#undef ATT_STORER
#undef ATT_LOAD
    const size_t qtok = (size_t)(qtok0 + l31);
    u32x2 gq[4][4];
#pragma unroll
    for (int dt = 0; dt < 4; ++dt)
#pragma unroll
        for (int qd = 0; qd < 4; ++qd) gq[dt][qd] = *(const u32x2*)(Z + qtok * LDZ + ZC_GATE + 1024 + h * 128 + 32 * dt + 8 * qd + 4 * hh);
    const float ltot = lrun + shx(lrun, 32, lane);
    const float inv = 1.0f / ltot;
#pragma unroll
    for (int dt = 0; dt < 4; ++dt)
#pragma unroll
        for (int qd = 0; qd < 4; ++qd) {
            const int d0 = h * 128 + 32 * dt + 8 * qd + 4 * hh;
            const u32x2 gg = gq[dt][qd];
            u32x2 o;
            o.x = pk2(O[dt][4 * qd + 0] * inv * bflo(gg.x), O[dt][4 * qd + 1] * inv * bfhi(gg.x));
            o.y = pk2(O[dt][4 * qd + 2] * inv * bflo(gg.y), O[dt][4 * qd + 3] * inv * bfhi(gg.y));
            *(u32x2*)(Y + qtok * DM + 1024 + d0) = o;
        }
}
__device__ __forceinline__ void att_phase(Frame& F, int l, int nunits) {
    LAS float* rpb_s = (LAS float*)(F.lds + ATT_RPB);
    const float* rpb = F.in[F.zi + I_RPB] + (size_t)l * 4 * 465;
    __syncthreads();
    for (int e = F.tid; e < 4 * 465; e += 512) rpb_s[e] = rpb[e] * 1.4426950408889634f;
    __syncthreads();
    for (int u = (F.bid + F.G - 64) % F.G; u < nunits; u += F.G) att_block_unit(F, u);
    __syncthreads();
}

constexpr int NPH_LAYER = 9, NPH = 2 + DEPTH * NPH_LAYER;
__global__ void __launch_bounds__(512, 2) fwd_kernel(Args args) {
    extern __shared__ __attribute__((aligned(16))) unsigned char lds[];
    Frame F;
    F.lds = (LAS unsigned char*)lds; F.tid = threadIdx.x; F.lane = F.tid & 63; F.wave = __builtin_amdgcn_readfirstlane(F.tid >> 6); F.wave0 = F.wave; F.G = gridDim.x; F.bid = blockIdx.x; F.G0 = F.G; F.bid0 = F.bid;
    F.ws = args.ws; F.ws0 = args.ws; F.in = args.in; F.zi = 0; F.out = args.out; F.out0 = args.out;
    volatile LAS unsigned* MISC = (volatile LAS unsigned*)(F.lds + MISC_OFF);
    if (F.tid < 64) MISC[F.tid] = 0u;
    __syncthreads();
    unsigned* ctl = (unsigned*)(F.ws + WS_CTL);
    XcdBarrier bar; bar.bar = ctl + 4096; bar.x = 0; bar.st = nullptr;
    if (!MK_MULTI) bar = xcd_barrier_post(ctl + 4096, MISC + 8, F.tid);
    const int lo = MK_MULTI ? args.p_lo : 0, hi = MK_MULTI ? args.p_hi : NPH;
#ifndef PHMASK
#define PHMASK 0xFFFFFFFFu
#endif
#define PH(k) ((PHMASK >> (k)) & 1u)
#ifndef REPMASK
#define REPMASK 0u
#endif
#define REP(k) for (int rep_ = 0; rep_ < (((REPMASK >> (k)) & 1u) ? 2 : 1); ++rep_)
#define IN(k) (lo <= (k) && (k) < hi)
#define SEAM(k) do { if (IN(k) && IN((k) + 1)) xcd_barrier(bar, F.wave0); } while (0)
    LAS unsigned char* ring = F.lds;
#define Zb ((bf16_t*)(F.ws + WS_Z))
#define Hb ((bf16_t*)(F.ws + WS_H))
#define Yb ((bf16_t*)(F.ws + WS_Y))
#define Xs ((bf16_t*)(F.ws + WS_XS))
#define ctxr ((float*)(F.ws + WS_CTXR))
#define ada_all ((const float*)(F.ws + WS_ADA))

    if (PH(0) && IN(0)) REP(0) { refresh(F); prologue_a(F); setup_layer(F, 0, 0, F.G); }
    SEAM(0);
    if (PH(1) && IN(1)) { refresh(F); ada_reduce(F); }
    SEAM(1);
    for (int l = 0; l < DEPTH; ++l) {
        const int base = 2 + l * NPH_LAYER;
        const int par = l & 1;
        const bool lastl = (l == DEPTH - 1); const int mrows = lastl ? MX / 256 : MT / 256;
#define ada_l (ada_all + (size_t)l * 17 * 6144)
        if (l == 0) {
            if (PH(2) && IN(base + 0)) REP(2) { refresh(F); ln_phase(F, 0, F.in[F.zi + I_X], F.in[F.zi + I_CTX], nullptr, nullptr, nullptr, nullptr, ada_l, MT); }
            SEAM(base + 0);
        }
        if (PH(3) && IN(base + 1)) REP(3) { refresh(F);
            { const bf16_t* Wi = (const bf16_t*)(F.ws + (par ? WS_WIN2 : WS_WIN)); const bf16_t* Ws = (const bf16_t*)(F.ws + (par ? WS_WSW2 : WS_WSW));
              pg8::Gemm g{Hb, Wi, DM, DM, DM, (size_t)((const char*)Ws - (const char*)Hb), (size_t)((const char*)Hb - (const char*)Wi)};
              pg8::G1Order S; S.G = F.G; S.c = F.bid; S.lastl = lastl;
              Epi1ab E{Epi1a{Zb, Xs, (const float*)(F.ws + WS_BIAS1A + (size_t)par * SMALL_STRIDE), (bf16_t*)(F.ws + WS_ZM)}, Epi1b{(bf16_t*)(F.ws + WS_VT), (bf16_t*)(F.ws + WS_VTS), (const float*)(F.ws + WS_BIAS1B + (size_t)par * SMALL_STRIDE)}, F.lds, 0};
              pg8::gemm_phase<Epi1ab, pg8::G1Order>(ring, g, S, E, F.tid); }
            if (l + 1 < DEPTH && F.bid >= 96) setup_layer(F, l + 1, 96, 160);
        }
        SEAM(base + 1);
        if (PH(4) && IN(base + 2)) REP(4) { refresh(F);
            { pg8::Gemm g{(const bf16_t*)(F.ws + (par ? WS_WFT2 : WS_WFT)), Zb + ZC_B, 512, LDZ, 512, 0, 0}; pg8::StaticOrder S; S.init(4, mrows, F.G, F.bid);
              EpiB1 E{(bf16_t*)(F.ws + WS_PTX), (bf16_t*)(F.ws + WS_PTC)};
              pg8::gemm_phase<EpiB1, pg8::StaticOrder>(ring, g, S, E, F.tid); }
            { pg8::Gemm g{Xs, (const bf16_t*)(F.ws + (par ? WS_MEND2 : WS_MEND)), XS_K, 512, 512, (size_t)XS_ROWS * XS_K * 2, (size_t)256 * 512 * 2}; pg8::BatchOrder S; S.init(5, 1, 32, F.G, (F.bid + F.G - 64) % F.G);
              EpiS5E E{(float*)(F.ws + WS_E)};
              pg8::gemm_phase<EpiS5E, pg8::BatchOrder>(ring, g, S, E, F.tid); }
            sgu_phase(F, l, (F.bid + F.G - 96) % F.G, lastl ? 1024 : 736);
            att_phase(F, l, lastl ? 512 : 576);
        }
        SEAM(base + 2);
        if (PH(5) && IN(base + 3)) REP(5) { refresh(F);
            { pg8::Gemm g{(const bf16_t*)(F.ws + WS_DFT), (const bf16_t*)(F.ws + WS_PTX), 4096, 4096, 4096, 0, 0}; pg8::StaticOrder S; S.init(8, 32, F.G, F.bid);
              EpiFB2<false> E{Yb, Zb, F.in[F.zi + I_BFNET] + (size_t)l * 512};
              pg8::gemm_phase<EpiFB2<false>, pg8::StaticOrder>(ring, g, S, E, F.tid); }
            if (!lastl) { pg8::Gemm g{(const bf16_t*)(F.ws + WS_DFT256), (const bf16_t*)(F.ws + WS_PTC), 512, 512, 512, 0, 0}; pg8::StaticOrder S; S.init(1, 32, F.G, (F.bid + 32) % F.G);
              EpiFB2<true> E{Yb, Zb, F.in[F.zi + I_BFNET] + (size_t)l * 512};
              pg8::gemm_phase<EpiFB2<true>, pg8::StaticOrder>(ring, g, S, E, F.tid); }
            s5_scan_phase(F, par);
        }
        SEAM(base + 3);
        if (PH(6) && IN(base + 4)) REP(6) { refresh(F);
            pg8::Gemm g{Xs, (const bf16_t*)(F.ws + WS_W3 + (size_t)par * W3_STRIDE), XS_K, XS_K, XS_K, (size_t)XS_ROWS * XS_K * 2, (size_t)512 * 768 * 2}; pg8::BatchOrder S; S.init(lastl ? 4 : 5, 2, 32, F.G, F.bid);
            EpiS5Y E{(bf16_t*)(F.ws + WS_YD)};
            pg8::gemm_phase<EpiS5Y, pg8::BatchOrder>(ring, g, S, E, F.tid);
            if (!lastl && F.bid >= 64) sgu_phase(F, l, 736 + F.bid - 64, 928);
        }
        SEAM(base + 4);
        if (PH(7) && IN(base + 5)) REP(7) { refresh(F);
            pg8::Gemm g{(const bf16_t*)(F.ws + WS_YD), (const bf16_t*)(F.ws + WS_WGLU + (size_t)par * WGLU_STRIDE), 512, 512, 512, 0, 0}; pg8::StaticOrder S; S.init(mrows, 2, F.G, F.bid);
            EpiGLU E{Yb, (const bf16_t*)(F.ws + WS_YD), Zb, F.in[F.zi + I_BGLU] + (size_t)l * 512};
            pg8::gemm_phase<EpiGLU, pg8::StaticOrder>(ring, g, S, E, F.tid);
            if (!lastl && F.bid >= 32) sgu_phase(F, l, 928 + F.bid - 32, 1152);
        }
        SEAM(base + 5);
        if (PH(8) && IN(base + 6)) REP(8) { refresh(F);
            pg8::Gemm g{Yb, (const bf16_t*)(F.ws + WS_WUP + (size_t)par * WUP_STRIDE), DM, 512, 512, (size_t)512 * 2, (size_t)DM * 512 * 2}; pg8::QuadOrder S; S.init(2 * mrows, DM / 256, F.G, F.bid);
            EpiUP E; E.Mo = Hb; E.Z = (const bf16_t*)(F.ws + WS_ZM);
#pragma unroll
            for (int a = 0; a < 2; ++a)
#pragma unroll
                for (int m = 0; m < 4; ++m) { E.ms[a][m][0] = (f32x4){0.f, 0.f, 0.f, 0.f}; E.ms[a][m][1] = (f32x4){0.f, 0.f, 0.f, 0.f}; E.sg0[m & 1] = (u32x4){0u, 0u, 0u, 0u}; }
            pg8::gemm_phase_m128<EpiUP, pg8::QuadOrder>(ring, g, S, E, F.tid);
        }
        SEAM(base + 6);
        if (PH(9) && IN(base + 7)) REP(9) { refresh(F);
            pg8::Gemm g{Hb, (const bf16_t*)(F.ws + WS_WO + (size_t)par * WO_STRIDE), DM, DM, DM, 0, 0};
            EpiOUT E{l == 0 ? F.in[F.zi + I_X] : F.out, l == 0 ? F.in[F.zi + I_CTX] : ctxr, F.out, ctxr, ada_l,
                     (const float*)pg8::uni((const char*)(F.in[F.zi + I_LNG] + (size_t)(l > 0 ? l - 1 : 0) * DM)), (const float*)pg8::uni((const char*)(F.in[F.zi + I_LNB] + (size_t)(l > 0 ? l - 1 : 0) * DM)), (const float*)(F.ws + WS_RS), l == 0, F.lds, 0};
            const int lim = (mrows * (DM / 256) / F.G) * F.G;
            { pg8::HeadOrder S; S.init(mrows, DM / 256, F.G, F.bid); S.lim = lim;
              pg8::gemm_phase<EpiOUT, pg8::HeadOrder>(ring, g, S, E, F.tid); }
            { pg8::TailOrder S; S.init(mrows, DM / 256, F.G, F.bid); S.lim = lim;
              EpiOUTh Eh{E};
              pg8::gemm_phase_n128<EpiOUTh, pg8::TailOrder>(ring, g, S, Eh, F.tid); }
        }
        SEAM(base + 7);
        if (PH(10) && IN(base + 8)) REP(10) { refresh(F); ln2_phase(F, F.out, ctxr, F.in[F.zi + I_LNG] + (size_t)l * DM, F.in[F.zi + I_LNB] + (size_t)l * DM, l + 1 < DEPTH ? ada_all + (size_t)(l + 1) * 17 * 6144 : nullptr, lastl ? MX : MT); }
        if (l + 1 < DEPTH) { if (IN(base + 8) && IN(base + 8 + 2)) xcd_barrier(bar, F.wave0); }
    }
#undef IN
#undef SEAM
#undef Zb
#undef Hb
#undef Yb
#undef Xs
#undef ctxr
#undef ada_all
#undef ada_l
}

extern "C" void kernel_launch(void* const* d_in, const int* in_sizes, int n_in, void* d_out, int out_size, void* d_ws, size_t ws_size, hipStream_t stream) {
    static int grid = 0;
    if (grid == 0) {
        if (n_in != 27 || out_size != MX * DM || ws_size < WS_END) { fprintf(stderr, "kernel_launch: unexpected problem (n_in %d, out %d, ws %zu < %zu)\n", n_in, out_size, ws_size, (size_t)WS_END); grid = -1; return; }
        int dev = 0, cus = 0, per_cu = 0;
        if (hipGetDevice(&dev) != hipSuccess || hipDeviceGetAttribute(&cus, hipDeviceAttributeMultiprocessorCount, dev) != hipSuccess) { grid = -1; return; }
        if (hipFuncSetAttribute((const void*)fwd_kernel, hipFuncAttributeMaxDynamicSharedMemorySize, LDS_BYTES) != hipSuccess) { fprintf(stderr, "kernel_launch: hipFuncSetAttribute failed\n"); grid = -1; return; }
        if (hipOccupancyMaxActiveBlocksPerMultiprocessor(&per_cu, (const void*)fwd_kernel, 512, LDS_BYTES) != hipSuccess || per_cu < 1) { fprintf(stderr, "kernel_launch: occupancy query says %d\n", per_cu); }
        (void)hipGetLastError();
        grid = cus;
        if (grid != 256) fprintf(stderr, "kernel_launch: %d CUs (built for 256)\n", grid);
    }
    if (grid < 0) return;
    (void)hipMemsetAsync((char*)d_ws + WS_CTL, 0, CTL_ZERO_BYTES, stream);
    Args a{};
    for (int i = 0; i < 27; ++i) a.in[i] = (const float*)d_in[i];
    a.out = (float*)d_out; a.ws = (unsigned char*)d_ws;
#if MK_MULTI
    for (int p = 0; p < NPH; ++p) { if (p >= 2 + NPH_LAYER && (p - 2) % NPH_LAYER == 0) continue; a.p_lo = p; a.p_hi = p + 1; hipLaunchKernelGGL(fwd_kernel, dim3(grid), dim3(512), LDS_BYTES, stream, a); }
#else
    a.p_lo = 0; a.p_hi = NPH;
    hipLaunchKernelGGL(fwd_kernel, dim3(grid), dim3(512), LDS_BYTES, stream, a);
#endif
}
```

```cpp
#include <hip/hip_runtime.h>
#include <cstdio>
#include <cstdint>

#ifndef MK_MULTI
#define MK_MULTI 0
#endif

#define LAS __attribute__((address_space(3)))
#define GAS __attribute__((address_space(1)))
typedef unsigned short bf16_t;
typedef short bf16x8 __attribute__((ext_vector_type(8)));
typedef short s16x4 __attribute__((ext_vector_type(4)));
typedef float f32x4 __attribute__((ext_vector_type(4)));
typedef float f32x2 __attribute__((ext_vector_type(2)));
typedef float f32x16 __attribute__((ext_vector_type(16)));
typedef unsigned u32x4 __attribute__((ext_vector_type(4)));
typedef unsigned u32x2 __attribute__((ext_vector_type(2)));
typedef __bf16 bf16x2_t __attribute__((ext_vector_type(2)));

constexpr int DM = 2048, NBATCH = 16, SEQ = 2048, CTXL = 256, DEPTH = 4;
constexpr int MX = NBATCH * SEQ, MC = NBATCH * CTXL, MT = MX + MC;
constexpr int WBR = 512, IN_COLS = 13824;
constexpr int OFF_D_U = 0, OFF_C_K = 512, OFF_C_V = 1024, OFF_C_Q = 1536, OFF_A_UV = 2048, OFF_B = 3072, OFF_GATE = 3584, OFF_MERGE = 5632;
constexpr int N1A = 12800, N1B = 1024, LDZ = 4096;
constexpr int ZC_B = 0, ZC_K = 512, ZC_Q = 1024, ZC_AU = 1536, ZC_GATE = 2048, ZC_MERGE = 4096;
constexpr int XS_ROWS = 1280, XS_K = 768;
constexpr float LN_EPS = 1e-6f;
constexpr float DN_ALPHA = 1.681792830507429f;

constexpr size_t MiB = 1u << 20;
constexpr size_t WS_CTL = 0, CTL_ZERO_BYTES = 1 * MiB;
constexpr size_t WS_ADA = 1 * MiB;
constexpr size_t WS_BIAS1A = 3 * MiB;
constexpr size_t WS_BIAS1B = 3 * MiB + 65536;
constexpr size_t WS_AT = 3 * MiB + 131072;
constexpr size_t AT_STRIDE = 32768;
constexpr size_t WS_WSGU = 3 * MiB + 262144;
constexpr size_t WS_DFT256 = 4 * MiB;
constexpr size_t WS_WFT = 5 * MiB;
constexpr size_t WS_DFT = 6 * MiB;
constexpr size_t WS_WIN = 22 * MiB;
constexpr size_t WS_WSW = 72 * MiB;
constexpr size_t WS_WUP = 76 * MiB, WUP_STRIDE = 8 * MiB;
constexpr size_t WS_WO = 92 * MiB, WO_STRIDE = 8 * MiB;
constexpr size_t WS_WGLU = 108 * MiB, WGLU_STRIDE = 512 * 1024;
constexpr size_t WS_MEND = 109 * MiB;
constexpr size_t WS_W3 = 117 * MiB, W3_STRIDE = 24 * MiB;
constexpr size_t WS_XS = 165 * MiB;
constexpr size_t WS_E = 225 * MiB;
constexpr size_t WS_YD = 265 * MiB;
constexpr size_t WS_H = 301 * MiB;
constexpr size_t WS_Y = 445 * MiB;
constexpr size_t WS_SW = 589 * MiB;
constexpr size_t WS_VT = WS_SW, WS_PTX = WS_SW + 36 * MiB, WS_PTC = WS_SW + 100 * MiB, WS_VTS = WS_SW + 108 * MiB;
constexpr size_t WS_CTXR = 733 * MiB;
constexpr size_t WS_Z = 765 * MiB;
constexpr size_t WS_ZM = 1053 * MiB;
constexpr size_t WS_ADAP = WS_Z;
constexpr size_t WS_RS = 1629 * MiB;
constexpr size_t WS_WIN2 = 1630 * MiB, WS_WSW2 = 1680 * MiB, WS_WFT2 = 1684 * MiB, WS_MEND2 = 1685 * MiB;
constexpr size_t SMALL_STRIDE = 512 * 1024;
constexpr size_t WS_END = 1693 * MiB;

constexpr int RING_BYTES = 131072;
constexpr int LDS_BYTES = 148480;
constexpr int MISC_OFF = 147456;

__device__ __forceinline__ unsigned pk2(float lo, float hi) { f32x2 v = {lo, hi}; bf16x2_t b = __builtin_convertvector(v, bf16x2_t); return __builtin_bit_cast(unsigned, b); }
__device__ __forceinline__ float bflo(unsigned w) { return __uint_as_float(w << 16); }
__device__ __forceinline__ float bfhi(unsigned w) { return __uint_as_float(w & 0xffff0000u); }
__device__ __forceinline__ float bf1(bf16_t b) { return __uint_as_float(((unsigned)b) << 16); }
__device__ __forceinline__ float sigm(float x) { return __builtin_amdgcn_rcpf(1.0f + __builtin_amdgcn_exp2f(-1.4426950408889634f * x)); }
__device__ __forceinline__ float silu_f(float x) { return x * sigm(x); }
__device__ __forceinline__ float gelu_t(float x) { return x * sigm(1.5957691216057308f * (x + 0.044715f * x * x * x)); }
__device__ __forceinline__ float shx(float v, int o, int lane) { return __builtin_bit_cast(float, __builtin_amdgcn_ds_bpermute((lane ^ o) << 2, __builtin_bit_cast(int, v))); }
__device__ __forceinline__ float wave_sum(float v, int lane) {
    (void)lane;
#define WS_DPP(ctrl) v += __builtin_bit_cast(float, __builtin_amdgcn_update_dpp(0, __builtin_bit_cast(int, v), ctrl, 0xF, 0xF, true))
    WS_DPP(0xB1); WS_DPP(0x4E); WS_DPP(0x141); WS_DPP(0x140);
#undef WS_DPP
    v += __builtin_bit_cast(float, __builtin_amdgcn_ds_swizzle(__builtin_bit_cast(int, v), 0x401F));
    float a = v, b = v;
    asm volatile("s_nop 1\n\tv_permlane32_swap_b32 %0, %1" : "+v"(a), "+v"(b));
    return a + b;
}
#define LDS_WAIT() asm volatile("s_waitcnt lgkmcnt(0)" ::: "memory")
#define VM_WAIT() asm volatile("s_waitcnt vmcnt(0)" ::: "memory")

namespace pg8 {
constexpr int BM = 256, BK = 64, HALF = 128, HTB = HALF * BK * 2, STAGE_BYTES = 8 * HTB, NXCD = 8, WGM = 4;
__host__ __device__ __forceinline__ int lds_byte(int r, int c) { const int st = (r >> 4) * 2 + (c >> 5), rr = r & 15, cc = c & 31, ob = rr * 64 + cc * 2; return st * 1024 + (ob ^ (((ob >> 9) & 1) << 5)); }
__host__ __device__ __forceinline__ void stage_rc(int b, int& R, int& C) { const int st = b / 1024, sb = b % 1024, swz = sb ^ (((sb >> 9) & 1) << 5); R = (st >> 1) * 16 + swz / 64; C = (st & 1) * 32 + (swz % 64) / 2; }
__host__ __device__ __forceinline__ int perm32(int rho) { const int n = rho >> 4, i = rho & 15; return 8 * (i >> 2) + 4 * n + (i & 3); }

struct Unit { int pm, pn, z; };
__device__ __forceinline__ const char* uni(const char* p) {
    const unsigned long long v = (unsigned long long)p;
    const unsigned lo = __builtin_amdgcn_readfirstlane((unsigned)v), hi = __builtin_amdgcn_readfirstlane((unsigned)(v >> 32));
    return (const char*)(((unsigned long long)hi << 32) | lo);
}
struct Gemm { const bf16_t* A; const bf16_t* Bt; int lda, ldb, K; size_t zA, zB; };

struct TileOrder {
    int nM, nN, nwg, G, c, pm0, pn0;
    __device__ void init(int nM_, int nN_, int G_, int c_, int pm0_ = 0, int pn0_ = 0) { nM = nM_; nN = nN_; nwg = nM * nN; G = G_; c = c_; pm0 = pm0_; pn0 = pn0_; }
    __device__ bool tile(int i, int& pm, int& pn) const { const long L = (long)i * G + c; if (L >= nwg) return false; tile_of((int)L, pm, pn); return true; }
    __device__ void tile_of(int L, int& pm, int& pn) const {
        int wgid = L; { const int q = nwg / NXCD, r = nwg % NXCD, xcd = wgid % NXCD, off = wgid / NXCD; wgid = (xcd < r ? xcd * (q + 1) : r * (q + 1) + (xcd - r) * q) + off; }
        const int nig = WGM * nN, gid = wgid / nig, fm = gid * WGM, gsz = (nM - fm) < WGM ? (nM - fm) : WGM;
        pm = pm0 + fm + ((wgid % nig) % gsz); pn = pn0 + (wgid % nig) / gsz;
    }
};
struct G1Order {
    int G, c; bool lastl;
    __device__ bool next(int i, Unit& u) const {
        int L = i * G + c; TileOrder t; const int mrows = lastl ? 128 : 144;
        const int n0 = mrows * 50; if (L < n0) { t.init(mrows, 50, G, 0); t.tile_of(L, u.pm, u.pn); u.z = 0; return true; } L -= n0;
        if (lastl) { if (L < 64) { t.init(16, 4, G, 0, 128, 0); t.tile_of(L, u.pm, u.pn); u.z = 0; return true; } L -= 64; }
        const int n2 = 4 * mrows; if (L < n2) { t.init(4, mrows, G, 0); t.tile_of(L, u.pm, u.pn); u.z = 1; return true; } L -= n2;
        if (lastl && L < 32) { t.init(2, 16, G, 0, 0, 128); t.tile_of(L, u.pm, u.pn); u.z = 1; return true; }
        return false;
    }
};
struct HeadOrder : TileOrder {
    int lim;
    __device__ bool next(int i, Unit& u) const { const int L = i * G + c; if (L >= lim) return false; u.z = 0; tile_of(L, u.pm, u.pn); return true; }
};
struct TailOrder : TileOrder {
    int lim;
    __device__ bool next(int i, Unit& u) const { if (i > 0) return false; const int L = lim + (c >> 1); if (L >= nwg) return false; u.z = 0; tile_of(L, u.pm, u.pn); u.pn = 2 * u.pn + (c & 1); return true; }
};
struct StaticOrder : TileOrder {
    __device__ bool next(int i, Unit& u) const { u.z = 0; return tile(i, u.pm, u.pn); }
};
struct QuadOrder : TileOrder {
    __device__ bool next(int i, Unit& u) const { u.z = i & 3; return tile(i >> 2, u.pm, u.pn); }
};
struct BatchOrder {
    int nM, nN, nZ, G, c;
    __device__ void init(int nM_, int nN_, int nZ_, int G_, int c_) { nM = nM_; nN = nN_; nZ = nZ_; G = G_; c = c_; }
    __device__ bool next(int i, Unit& u) const {
        const int L = i * G + c; if (L >= nM * nN * nZ) return false;
        u.z = L / (nM * nN); const int r = L % (nM * nN); u.pm = r / nN; u.pn = r % nN; return true;
    }
};

template <class E, class = void> struct HasAhead { static constexpr bool value = false; };
template <class E> struct HasAhead<E, decltype((void)E::AHEAD)> { static constexpr bool value = true; };
template <class E, class = void> struct HasPre { static constexpr bool value = false; };
template <class E> struct HasPre<E, decltype((void)E::HAS_PRE)> { static constexpr bool value = true; };
template <class Epi, class Sched, bool ALIGN_EPI = true>
__device__ __forceinline__ void gemm_phase(LAS unsigned char* lds, const Gemm g, const Sched& S, Epi& E, int tid) {
    asm volatile("" : "+v"(tid));
    const int wid = __builtin_amdgcn_readfirstlane(tid >> 6), lane = tid & 63, wr = wid >> 2, wc = wid & 3, fr = lane & 15, fq = lane >> 4;
    const int K = g.K, nt = K / BK;
    unsigned voffA[2], voffB[2];
#pragma unroll
    for (int i = 0; i < 2; ++i) { int R, C; stage_rc(tid * 16 + i * 8192, R, C); const int Rb = Epi::PERM ? ((R & ~31) + perm32(R & 31)) : R;
        voffA[i] = (unsigned)(R * g.lda + C) * 2u; voffB[i] = (unsigned)(Rb * g.ldb + C) * 2u; }
    const size_t kstep = (size_t)(BK * 2);
    const size_t hstepA = (size_t)HALF * g.lda * 2, hstepB = (size_t)HALF * g.ldb * 2;
    const size_t tstepA = 2 * hstepA, tstepB = 2 * hstepB;
    const unsigned ldsw = (unsigned)wid * 1024u;
    const int aoff = lds_byte(wr * 64 + fr, fq * 8), boff = lds_byte(wc * 32 + fr, fq * 8);
#define PG8_SA(b, h) (((b) * 2 + (h)) * HTB)
#define PG8_SB(b, h) ((4 + (b) * 2 + (h)) * HTB)
#define PG8_STAGE(bufoff, gbase, voff) do { _Pragma("unroll") for (int _i = 0; _i < 2; ++_i) \
        __builtin_amdgcn_global_load_lds((const unsigned*)((const char*)(gbase) + (voff)[_i]), (LAS unsigned*)(lds + (bufoff) + ldsw + _i * 8192), 16, 0, 0); } while (0)
#define PG8_LDA(dst, b, h) do { _Pragma("unroll") for (int m = 0; m < 4; ++m) _Pragma("unroll") for (int k = 0; k < 2; ++k) dst[m][k] = *(const LAS bf16x8*)(lds + PG8_SA(b, h) + aoff + m * 2048 + k * 1024); } while (0)
#define PG8_LDB(dst, b, h) do { _Pragma("unroll") for (int n = 0; n < 2; ++n) _Pragma("unroll") for (int k = 0; k < 2; ++k) dst[n][k] = *(const LAS bf16x8*)(lds + PG8_SB(b, h) + boff + n * 2048 + k * 1024); } while (0)
#define PG8_MMA(ai, bj, At, Bt) do { __builtin_amdgcn_s_setprio(1); _Pragma("unroll") for (int m = 0; m < 4; ++m) _Pragma("unroll") for (int n = 0; n < 2; ++n) _Pragma("unroll") for (int k = 0; k < 2; ++k) \
        acc[ai][bj][m][n] = __builtin_amdgcn_mfma_f32_16x16x32_bf16(Bt[n][k], At[m][k], acc[ai][bj][m][n], 0, 0, 0); __builtin_amdgcn_s_setprio(0); } while (0)
#define PG8_WAIT_V(n) asm volatile("s_waitcnt vmcnt(" #n ")" ::: "memory")
#define PG8_WAIT_L(n) asm volatile("s_waitcnt lgkmcnt(" #n ")" ::: "memory")
#define PG8_BAR __builtin_amdgcn_s_barrier()
#define PG8_SCHED __builtin_amdgcn_sched_barrier(0)
    Unit cur, nxt; int ui = 0;
    if (!S.next(0, cur)) return;
    f32x4 acc[2][2][4][2];
#pragma unroll
    for (int a = 0; a < 2; ++a)
#pragma unroll
        for (int b = 0; b < 2; ++b)
#pragma unroll
            for (int m = 0; m < 4; ++m)
#pragma unroll
                for (int n = 0; n < 2; ++n) acc[a][b][m][n] = (f32x4){0.f, 0.f, 0.f, 0.f};
    bf16x8 At[4][2], B0[2][2], B1[2][2];
    const char* cA = (const char*)g.A + (size_t)cur.pm * tstepA + (size_t)cur.z * g.zA; const char* cB = (const char*)g.Bt + (size_t)cur.pn * tstepB + (size_t)cur.z * g.zB;
    PG8_STAGE(PG8_SB(0, 0), cB, voffB); PG8_STAGE(PG8_SB(0, 1), cB + hstepB, voffB); PG8_STAGE(PG8_SA(0, 0), cA, voffA); PG8_STAGE(PG8_SA(0, 1), cA + hstepA, voffA);
    if (wr == 1) PG8_BAR;
    PG8_WAIT_V(2); PG8_BAR;
    PG8_STAGE(PG8_SB(1, 0), cB + kstep, voffB); PG8_STAGE(PG8_SA(1, 0), cA + kstep, voffA); PG8_STAGE(PG8_SB(1, 1), cB + hstepB + kstep, voffB);
    PG8_WAIT_V(6); PG8_BAR;
    for (;;) {
        const bool has_next = S.next(ui + 1, nxt);
        const char* nA = has_next ? (const char*)g.A + (size_t)nxt.pm * tstepA + (size_t)nxt.z * g.zA : cA; const char* nB = has_next ? (const char*)g.Bt + (size_t)nxt.pn * tstepB + (size_t)nxt.z * g.zB : cB;
        if constexpr (HasPre<Epi>::value) E.pre(cur, lds, wid, lane, ui & 1);
        for (int t = 0; t < nt; t += 2) {
            const bool last = (t == nt - 2);
            const char* a1 = cA + (size_t)(t + 1) * kstep;
            const char* a2 = last ? nA : cA + (size_t)(t + 2) * kstep; const char* b2 = last ? nB : cB + (size_t)(t + 2) * kstep;
            const char* a3 = a2 + kstep; const char* b3 = b2 + kstep;
            PG8_LDB(B0, 0, 0); PG8_LDB(B1, 0, 1); PG8_SCHED; PG8_LDA(At, 0, 0); PG8_STAGE(PG8_SA(1, 1), a1 + hstepA, voffA);
            PG8_WAIT_V(8); PG8_WAIT_L(0); PG8_BAR; PG8_MMA(0, 0, At, B0); PG8_MMA(0, 1, At, B1); PG8_BAR; PG8_SCHED;
            PG8_LDA(At, 0, 1); PG8_STAGE(PG8_SB(0, 0), b2, voffB); PG8_STAGE(PG8_SB(0, 1), b2 + hstepB, voffB); PG8_STAGE(PG8_SA(0, 0), a2, voffA);
            PG8_WAIT_V(8); PG8_WAIT_L(0); PG8_BAR; PG8_MMA(1, 0, At, B0); PG8_MMA(1, 1, At, B1); PG8_BAR; PG8_SCHED;
            PG8_LDB(B0, 1, 0); PG8_LDB(B1, 1, 1); PG8_SCHED; PG8_LDA(At, 1, 0); PG8_STAGE(PG8_SA(0, 1), a2 + hstepA, voffA);
            PG8_WAIT_V(8); PG8_WAIT_L(0); PG8_BAR; PG8_MMA(0, 0, At, B0); PG8_MMA(0, 1, At, B1); PG8_BAR; PG8_SCHED;
            PG8_LDA(At, 1, 1); PG8_STAGE(PG8_SB(1, 0), b3, voffB); PG8_STAGE(PG8_SB(1, 1), b3 + hstepB, voffB); PG8_STAGE(PG8_SA(1, 0), a3, voffA);
            PG8_WAIT_V(8); PG8_WAIT_L(0); PG8_BAR; PG8_MMA(1, 0, At, B0); PG8_MMA(1, 1, At, B1); PG8_BAR; PG8_SCHED;
        }
        if constexpr (ALIGN_EPI) { if (wr == 0) PG8_BAR; }
        if constexpr (HasPre<Epi>::value) E.slot = ui & 1;
        E(acc, cur, wr, wc, fr, fq);
        if (!has_next) break;
#pragma unroll
        for (int a = 0; a < 2; ++a)
#pragma unroll
            for (int b = 0; b < 2; ++b)
#pragma unroll
                for (int m = 0; m < 4; ++m)
#pragma unroll
                    for (int n = 0; n < 2; ++n) acc[a][b][m][n] = (f32x4){0.f, 0.f, 0.f, 0.f};
        cur = nxt; cA = nA; cB = nB; ++ui;
        if constexpr (ALIGN_EPI) { if (wr == 1) PG8_BAR; }
    }
    PG8_WAIT_V(0);
    if constexpr (!ALIGN_EPI) { if (wr == 0) PG8_BAR; }
    PG8_BAR;
#undef PG8_SA
#undef PG8_SB
#undef PG8_STAGE
#undef PG8_LDA
#undef PG8_LDB
#undef PG8_MMA
#undef PG8_WAIT_V
#undef PG8_WAIT_L
#undef PG8_BAR
#undef PG8_SCHED
}

template <class Epi, class Sched, bool ALIGN_EPI = true>
__device__ __forceinline__ void gemm_phase_n128(LAS unsigned char* lds, const Gemm g, const Sched& S, Epi& E, int tid) {
    asm volatile("" : "+v"(tid));
    const int wid = __builtin_amdgcn_readfirstlane(tid >> 6), lane = tid & 63, wr = wid >> 2, wc = wid & 3, fr = lane & 15, fq = lane >> 4;
    const int K = g.K, nt = K / BK;
    unsigned voffA[2], voffB[2];
#pragma unroll
    for (int i = 0; i < 2; ++i) { int R, C; stage_rc(tid * 16 + i * 8192, R, C); const int Rb = Epi::PERM ? ((R & ~31) + perm32(R & 31)) : R;
        voffA[i] = (unsigned)(R * g.lda + C) * 2u; voffB[i] = (unsigned)(Rb * g.ldb + C) * 2u; }
    const size_t kstep = (size_t)(BK * 2);
    const size_t hstepA = (size_t)HALF * g.lda * 2, hstepB = (size_t)HALF * g.ldb * 2;
    const size_t tstepA = 2 * hstepA;
    const unsigned ldsw = (unsigned)wid * 1024u;
    const int aoff = lds_byte(wr * 64 + fr, fq * 8), boff = lds_byte(wc * 32 + fr, fq * 8);
#define PG8_SA(b, h) (((b) * 2 + (h)) * HTB)
#define PG8_SB(b, h) ((4 + (b) * 2 + (h)) * HTB)
#define PG8_STAGE(bufoff, gbase, voff) do { _Pragma("unroll") for (int _i = 0; _i < 2; ++_i) \
        __builtin_amdgcn_global_load_lds((const unsigned*)((const char*)(gbase) + (voff)[_i]), (LAS unsigned*)(lds + (bufoff) + ldsw + _i * 8192), 16, 0, 0); } while (0)
#define PG8_LDA(dst, b, h) do { _Pragma("unroll") for (int m = 0; m < 4; ++m) _Pragma("unroll") for (int k = 0; k < 2; ++k) dst[m][k] = *(const LAS bf16x8*)(lds + PG8_SA(b, h) + aoff + m * 2048 + k * 1024); } while (0)
#define PG8_LDB(dst, b, h) do { _Pragma("unroll") for (int n = 0; n < 2; ++n) _Pragma("unroll") for (int k = 0; k < 2; ++k) dst[n][k] = *(const LAS bf16x8*)(lds + PG8_SB(b, h) + boff + n * 2048 + k * 1024); } while (0)
#define PG8_MMA(ai, At, Bt) do { __builtin_amdgcn_s_setprio(1); _Pragma("unroll") for (int m = 0; m < 4; ++m) _Pragma("unroll") for (int n = 0; n < 2; ++n) _Pragma("unroll") for (int k = 0; k < 2; ++k) \
        acc[ai][m][n] = __builtin_amdgcn_mfma_f32_16x16x32_bf16(Bt[n][k], At[m][k], acc[ai][m][n], 0, 0, 0); __builtin_amdgcn_s_setprio(0); } while (0)
#define PG8_WAIT_V(n) asm volatile("s_waitcnt vmcnt(" #n ")" ::: "memory")
#define PG8_WAIT_L(n) asm volatile("s_waitcnt lgkmcnt(" #n ")" ::: "memory")
#define PG8_BAR __builtin_amdgcn_s_barrier()
#define PG8_SCHED __builtin_amdgcn_sched_barrier(0)
    Unit cur, nxt; int ui = 0;
    if (!S.next(0, cur)) return;
    f32x4 acc[2][4][2];
#pragma unroll
    for (int a = 0; a < 2; ++a)
#pragma unroll
        for (int m = 0; m < 4; ++m)
#pragma unroll
            for (int n = 0; n < 2; ++n) acc[a][m][n] = (f32x4){0.f, 0.f, 0.f, 0.f};
    bf16x8 At[4][2], B0[2][2];
    const char* cA = (const char*)g.A + (size_t)cur.pm * tstepA + (size_t)cur.z * g.zA; const char* cB = (const char*)g.Bt + (size_t)cur.pn * hstepB + (size_t)cur.z * g.zB;
    PG8_STAGE(PG8_SB(0, 0), cB, voffB); PG8_STAGE(PG8_SA(0, 0), cA, voffA); PG8_STAGE(PG8_SA(0, 1), cA + hstepA, voffA);
    if (wr == 1) PG8_BAR;
    PG8_WAIT_V(2); PG8_BAR;
    PG8_STAGE(PG8_SB(1, 0), cB + kstep, voffB); PG8_STAGE(PG8_SA(1, 0), cA + kstep, voffA);
    PG8_WAIT_V(4); PG8_BAR;
    for (;;) {
        const bool has_next = S.next(ui + 1, nxt);
        const char* nA = has_next ? (const char*)g.A + (size_t)nxt.pm * tstepA + (size_t)nxt.z * g.zA : cA; const char* nB = has_next ? (const char*)g.Bt + (size_t)nxt.pn * hstepB + (size_t)nxt.z * g.zB : cB;
        for (int t = 0; t < nt; t += 2) {
            const bool last = (t == nt - 2);
            const char* a1 = cA + (size_t)(t + 1) * kstep;
            const char* a2 = last ? nA : cA + (size_t)(t + 2) * kstep; const char* b2 = last ? nB : cB + (size_t)(t + 2) * kstep;
            const char* a3 = a2 + kstep; const char* b3 = b2 + kstep;
            PG8_LDB(B0, 0, 0); PG8_SCHED; PG8_LDA(At, 0, 0); PG8_STAGE(PG8_SA(1, 1), a1 + hstepA, voffA);
            PG8_WAIT_V(6); PG8_WAIT_L(0); PG8_BAR; PG8_MMA(0, At, B0); PG8_BAR; PG8_SCHED;
            PG8_LDA(At, 0, 1); PG8_STAGE(PG8_SB(0, 0), b2, voffB); PG8_STAGE(PG8_SA(0, 0), a2, voffA);
            PG8_WAIT_V(6); PG8_WAIT_L(0); PG8_BAR; PG8_MMA(1, At, B0); PG8_BAR; PG8_SCHED;
            PG8_LDB(B0, 1, 0); PG8_SCHED; PG8_LDA(At, 1, 0); PG8_STAGE(PG8_SA(0, 1), a2 + hstepA, voffA);
            PG8_WAIT_V(6); PG8_WAIT_L(0); PG8_BAR; PG8_MMA(0, At, B0); PG8_BAR; PG8_SCHED;
            PG8_LDA(At, 1, 1); PG8_STAGE(PG8_SB(1, 0), b3, voffB); PG8_STAGE(PG8_SA(1, 0), a3, voffA);
            PG8_WAIT_V(6); PG8_WAIT_L(0); PG8_BAR; PG8_MMA(1, At, B0); PG8_BAR; PG8_SCHED;
        }
        if constexpr (ALIGN_EPI) { if (wr == 0) PG8_BAR; }
        E(acc, cur, wr, wc, fr, fq);
        if (!has_next) break;
#pragma unroll
        for (int a = 0; a < 2; ++a)
#pragma unroll
            for (int m = 0; m < 4; ++m)
#pragma unroll
                for (int n = 0; n < 2; ++n) acc[a][m][n] = (f32x4){0.f, 0.f, 0.f, 0.f};
        cur = nxt; cA = nA; cB = nB; ++ui;
        if constexpr (ALIGN_EPI) { if (wr == 1) PG8_BAR; }
    }
    PG8_WAIT_V(0);
    if constexpr (!ALIGN_EPI) { if (wr == 0) PG8_BAR; }
    PG8_BAR;
#undef PG8_SA
#undef PG8_SB
#undef PG8_STAGE
#undef PG8_LDA
#undef PG8_LDB
#undef PG8_MMA
#undef PG8_WAIT_V
#undef PG8_WAIT_L
#undef PG8_BAR
#undef PG8_SCHED
}
constexpr int M_STG = 49152;
template <class Epi, class Sched, bool ALIGN_EPI = true>
__device__ __forceinline__ void gemm_phase_m128(LAS unsigned char* lds, const Gemm g, const Sched& S, Epi& E, int tid) {
    asm volatile("" : "+v"(tid));
    const int wid = __builtin_amdgcn_readfirstlane(tid >> 6), lane = tid & 63, wr = wid >> 2, wc = wid & 3, fr = lane & 15, fq = lane >> 4;
    const int K = g.K, nt = K / BK;
    unsigned voffA[2], voffB[2];
#pragma unroll
    for (int i = 0; i < 2; ++i) { int R, C; stage_rc(tid * 16 + i * 8192, R, C); const int Rb = Epi::PERM ? ((R & ~31) + perm32(R & 31)) : R;
        voffA[i] = (unsigned)(R * g.lda + C) * 2u; voffB[i] = (unsigned)(Rb * g.ldb + C) * 2u; }
    const size_t kstep = (size_t)(BK * 2);
    const size_t hstepA = (size_t)HALF * g.lda * 2, hstepB = (size_t)HALF * g.ldb * 2;
    const unsigned ldsw = (unsigned)wid * 1024u;
    const int aoff = lds_byte(wr * 64 + fr, fq * 8), boff = lds_byte(wc * 32 + fr, fq * 8);
#define PG8_STAGE(slot, part, gbase, voff) do { _Pragma("unroll") for (int _i = 0; _i < 2; ++_i) \
        __builtin_amdgcn_global_load_lds((const unsigned*)((const char*)(gbase) + (voff)[_i]), (LAS unsigned*)(lds + (slot) * M_STG + (part) * 16384 + ldsw + _i * 8192), 16, 0, 0); } while (0)
#define PG8_LDA(dst, so) do { _Pragma("unroll") for (int m = 0; m < 4; ++m) _Pragma("unroll") for (int k = 0; k < 2; ++k) dst[m][k] = *(const LAS bf16x8*)(lds + (so) + aoff + m * 2048 + k * 1024); } while (0)
#define PG8_LDB(dst, so, h) do { _Pragma("unroll") for (int n = 0; n < 2; ++n) _Pragma("unroll") for (int k = 0; k < 2; ++k) dst[n][k] = *(const LAS bf16x8*)(lds + (so) + 16384 * (1 + (h)) + boff + n * 2048 + k * 1024); } while (0)
#define PG8_MMA(bj, At, Bt) do { __builtin_amdgcn_s_setprio(1); _Pragma("unroll") for (int m = 0; m < 4; ++m) _Pragma("unroll") for (int n = 0; n < 2; ++n) _Pragma("unroll") for (int k = 0; k < 2; ++k) \
        acc[bj][m][n] = __builtin_amdgcn_mfma_f32_16x16x32_bf16(Bt[n][k], At[m][k], acc[bj][m][n], 0, 0, 0); __builtin_amdgcn_s_setprio(0); } while (0)
#define PG8_WAIT_V(n) asm volatile("s_waitcnt vmcnt(" #n ")" ::: "memory")
#define PG8_WAIT_L(n) asm volatile("s_waitcnt lgkmcnt(" #n ")" ::: "memory")
#define PG8_BAR __builtin_amdgcn_s_barrier()
#define PG8_SCHED __builtin_amdgcn_sched_barrier(0)
    Unit cur, nxt; int ui = 0;
    if (!S.next(0, cur)) return;
    f32x4 acc[2][4][2];
#pragma unroll
    for (int a = 0; a < 2; ++a)
#pragma unroll
        for (int m = 0; m < 4; ++m)
#pragma unroll
            for (int n = 0; n < 2; ++n) acc[a][m][n] = (f32x4){0.f, 0.f, 0.f, 0.f};
    bf16x8 At[4][2], B0[2][2];
    const char* cA = (const char*)g.A + (size_t)cur.pm * hstepA + (size_t)cur.z * g.zA; const char* cB = (const char*)g.Bt + (size_t)cur.pn * 2 * hstepB + (size_t)cur.z * g.zB;
    PG8_STAGE(0, 0, cA, voffA); PG8_STAGE(0, 1, cB, voffB); PG8_STAGE(0, 2, cB + hstepB, voffB);
    if (wr == 1) PG8_BAR;
    PG8_WAIT_V(0); PG8_BAR;
    PG8_STAGE(1, 0, cA + kstep, voffA); PG8_STAGE(1, 1, cB + kstep, voffB); PG8_STAGE(1, 2, cB + hstepB + kstep, voffB);
    PG8_BAR;
    if constexpr (HasAhead<Epi>::value) E.load(cur, wr, wc, fr, fq);
    int cs = 0;
    for (;;) {
        const bool has_next = S.next(ui + 1, nxt);
        const char* nA = has_next ? (const char*)g.A + (size_t)nxt.pm * hstepA + (size_t)nxt.z * g.zA : cA; const char* nB = has_next ? (const char*)g.Bt + (size_t)nxt.pn * 2 * hstepB + (size_t)nxt.z * g.zB : cB;
        for (int t = 0; t < nt; ++t) {
            const bool over = (t + 2 >= nt);
            const char* a2 = uni(over ? nA + (size_t)(t + 2 - nt) * kstep : cA + (size_t)(t + 2) * kstep);
            const char* b2 = uni(over ? nB + (size_t)(t + 2 - nt) * kstep : cB + (size_t)(t + 2) * kstep);
            const int so = cs * M_STG; int ts = cs + 2; ts = ts >= 3 ? ts - 3 : ts;
            PG8_LDB(B0, so, 0); PG8_SCHED; PG8_LDA(At, so); PG8_STAGE(ts, 0, a2, voffA); PG8_STAGE(ts, 1, b2, voffB); PG8_STAGE(ts, 2, b2 + hstepB, voffB);
            if constexpr (HasAhead<Epi>::value) { if (t == 0) PG8_WAIT_V(14); else PG8_WAIT_V(6); }
            else {
                if (Epi::NPRE > 0 && t == nt - 2) E.prefetch(cur, wr, wc, fr, fq);
                if (Epi::NPRE > 0 && t >= nt - 2) { static_assert(Epi::NPRE == 0 || Epi::NPRE == 2, "wait literals"); PG8_WAIT_V(8); } else PG8_WAIT_V(6);
            }
            PG8_WAIT_L(0); PG8_BAR; PG8_MMA(0, At, B0); PG8_SCHED; PG8_LDB(B0, so, 1); PG8_WAIT_L(0); PG8_MMA(1, At, B0); PG8_BAR; PG8_SCHED;
            cs = (cs == 2) ? 0 : cs + 1;
        }
        if constexpr (ALIGN_EPI) { if (wr == 0) PG8_BAR; }
        if constexpr (HasAhead<Epi>::value) E.run(acc, cur, nxt, has_next, wr, wc, fr, fq); else E(acc, cur, wr, wc, fr, fq);
        if (!has_next) break;
#pragma unroll
        for (int a = 0; a < 2; ++a)
#pragma unroll
            for (int m = 0; m < 4; ++m)
#pragma unroll
                for (int n = 0; n < 2; ++n) acc[a][m][n] = (f32x4){0.f, 0.f, 0.f, 0.f};
        cur = nxt; cA = nA; cB = nB; ++ui;
        if constexpr (ALIGN_EPI) { if (wr == 1) PG8_BAR; }
    }
    PG8_WAIT_V(0);
    if constexpr (!ALIGN_EPI) { if (wr == 0) PG8_BAR; }
    PG8_BAR;
#undef PG8_STAGE
#undef PG8_LDA
#undef PG8_LDB
#undef PG8_MMA
#undef PG8_WAIT_V
#undef PG8_WAIT_L
#undef PG8_BAR
#undef PG8_SCHED
}
}
using pg8::Unit;

#define XB_TMO      128
#define XB_XCNT(j)  (256  + 64 * (j))
#define XB_XSUB(j)  (1280 + 64 * (j))
#define XB_XGEN(j)  (2304 + 64 * (j))
#define XB_TOP      3328
#define XB_TOPGEN   3392
#define XCD_BAR_WORDS 3456
#define XB_SPIN_CAP (1u << 18)
__device__ __forceinline__ unsigned xb_ld(unsigned* p)              { return __hip_atomic_load(p, __ATOMIC_RELAXED, __HIP_MEMORY_SCOPE_AGENT); }
__device__ __forceinline__ unsigned xb_add(unsigned* p, unsigned v) { return __hip_atomic_fetch_add(p, v, __ATOMIC_RELAXED, __HIP_MEMORY_SCOPE_AGENT); }
__device__ __forceinline__ unsigned xb_xcc_id() { return (unsigned)__builtin_amdgcn_s_getreg((3 << 11) | 20) & 0xFu; }
#define XB_SPIN(cond, bar) do { unsigned _sp = 0; while (cond) { __builtin_amdgcn_s_sleep(1); \
    if ((++_sp & 255u) == 0u) { if (xb_ld(&(bar)[XB_TMO])) break; if (_sp > XB_SPIN_CAP) { atomicAdd(&(bar)[XB_TMO], 1u); break; } } } } while (0)
struct XcdBarrier { unsigned* bar; unsigned x; volatile LAS unsigned* st; };
__device__ __forceinline__ XcdBarrier xcd_barrier_post(unsigned* bar, volatile LAS unsigned* st, int tid) {
    XcdBarrier b; b.bar = bar; b.x = xb_xcc_id(); b.st = st;
    if (tid == 0) (void)xb_add(&bar[XB_XCNT(b.x)], 1u);
    return b;
}
__device__ __forceinline__ void xcd_barrier_complete(unsigned* bar, unsigned x, unsigned& nloc, unsigned& nx) {
    const unsigned G = gridDim.x * gridDim.y * gridDim.z;
    unsigned sum, cnt, mine, sp = 0u;
    for (;;) {
        sum = 0u; cnt = 0u; mine = 0u;
#pragma unroll
        for (unsigned j = 0; j < 16; ++j) { const unsigned c = xb_ld(&bar[XB_XCNT(j)]); sum += c; cnt += (c > 0u) ? 1u : 0u; mine = (j == x) ? c : mine; }
        if (sum == G) break;
        __builtin_amdgcn_s_sleep(1);
        if ((++sp & 255u) == 0u) { if (xb_ld(&bar[XB_TMO])) break; if (sp > XB_SPIN_CAP) { atomicAdd(&bar[XB_TMO], 1u); break; } }
    }
    nloc = mine > 0u ? mine : 1u; nx = cnt > 0u ? cnt : 1u;
}
__device__ __forceinline__ void xcd_barrier(const XcdBarrier& b, int wave0) {
    asm volatile("s_waitcnt vmcnt(0)" ::: "memory");
    __syncthreads();
    unsigned zv = 0u; asm volatile("" : "+v"(zv));
    const int tid = wave0 * 64 + (int)__builtin_amdgcn_mbcnt_hi(~0u, __builtin_amdgcn_mbcnt_lo(~0u, zv));
    if (tid == 0) {
        unsigned* bar = b.bar; { size_t zo = 0; asm volatile("" : "+s"(zo)); bar += zo; }
        unsigned bx = b.x; asm volatile("" : "+s"(bx));
        __builtin_amdgcn_s_waitcnt(0);
        unsigned nloc = b.st[0], nx = b.st[1];
        if (nloc == 0u) { xcd_barrier_complete(bar, bx, nloc, nx); b.st[0] = nloc; b.st[1] = nx; }
        const unsigned old = xb_add(&bar[XB_XSUB(bx)], 1u);
        const unsigned gen = old / nloc;
        if (old + 1u == (gen + 1u) * nloc) {
            __builtin_amdgcn_fence(__ATOMIC_RELEASE, "agent");
            asm volatile("s_waitcnt vmcnt(0)" ::: "memory");
            const unsigned og = xb_add(&bar[XB_TOP], 1u);
            const unsigned tg = og / nx;
            if (og + 1u == (tg + 1u) * nx) xb_add(&bar[XB_TOPGEN], 1u);
            else XB_SPIN(xb_ld(&bar[XB_TOPGEN]) == tg, bar);
            __builtin_amdgcn_fence(__ATOMIC_ACQUIRE, "agent");
            xb_add(&bar[XB_XGEN(bx)], 1u);
            asm volatile("s_waitcnt vmcnt(0)" ::: "memory");
        } else {
            XB_SPIN(xb_ld(&bar[XB_XGEN(bx)]) == gen, bar);
            __builtin_amdgcn_fence(__ATOMIC_ACQUIRE, "agent");
            asm volatile("s_waitcnt vmcnt(0)" ::: "memory");
        }
    }
    __syncthreads();
}

struct Args { const float* in[27]; float* out; unsigned char* ws; int p_lo, p_hi; };
enum { I_X = 0, I_C, I_CTX, I_CCTX, I_WADA, I_BADA, I_WIN, I_BIN, I_WSGU, I_BSGU, I_WFNET, I_BFNET, I_RPB, I_ARE, I_AIM, I_LOGDT, I_BRE, I_BIM, I_CRE, I_CIM, I_S5D, I_WGLU, I_BGLU, I_WUP, I_WO, I_LNG, I_LNB };

struct Frame {
    LAS unsigned char* lds;
    int tid, lane, wave, wave0, G, bid, G0, bid0;
    unsigned char* ws; unsigned char* ws0;
    const float* const* in; int zi;
    float* out; float* out0;
};

__device__ __forceinline__ void refresh(Frame& F) {
    unsigned zv = 0u; asm volatile("" : "+v"(zv));
    const int ln = (int)__builtin_amdgcn_mbcnt_hi(~0u, __builtin_amdgcn_mbcnt_lo(~0u, zv));
    F.lane = ln; F.wave = F.wave0; F.tid = F.wave0 * 64 + ln;
    size_t z = 0; asm volatile("" : "+s"(z));
    { int zi = 0; asm volatile("" : "+s"(zi)); F.zi = zi; F.G = F.G0 + zi; F.bid = F.bid0 + zi; }
    F.ws = F.ws0 + z; F.out = F.out0 + z;
}
template <int MODE> __device__ __forceinline__ f32x2 act2(f32x2 v) {
    if (MODE == 0) return v;
    if (MODE == 1) return v * 0.12751743082459868f;
    f32x2 t;
    if (MODE == 2) t = v * (v * v * (-0.10294324849420653f) + (-2.302208198144325f));
    else t = v * (-1.4426950408889634f);
    f32x2 e; e.x = __builtin_amdgcn_exp2f(t.x); e.y = __builtin_amdgcn_exp2f(t.y);
    e = e + 1.0f;
    f32x2 r; r.x = __builtin_amdgcn_rcpf(e.x); r.y = __builtin_amdgcn_rcpf(e.y);
    if (MODE == 4) return r;
    return v * r;
}
constexpr int EPI_BIAS_LDS = 131072;
struct Epi1a {
    static constexpr bool PERM = true;
    bf16_t* Z; bf16_t* Xs; const float* bias; bf16_t* Zm;
    __device__ __forceinline__ void run_merge(const f32x4 (&acc)[2][2][4][2], const f32x4 (&bv)[2][2], const Unit& u, int wr, int wc, int fr, int fq) const {
        const int pnm = u.pn - 16;
        bf16_t* tb = Zm + ((size_t)(((pnm >> 3) * 144 + u.pm) * 8 + (pnm & 7))) * 65536 + (wr * 64 + fr) * 256 + wc * 32 + 8 * fq;
#pragma unroll
        for (int ai = 0; ai < 2; ++ai)
#pragma unroll
            for (int m = 0; m < 4; ++m)
#pragma unroll
                for (int bj = 0; bj < 2; ++bj) {
                    const f32x4 v0 = acc[ai][bj][m][0] + bv[bj][0], v1 = acc[ai][bj][m][1] + bv[bj][1];
                    const f32x2 o0 = act2<4>((f32x2){v0[0], v0[1]}), o1 = act2<4>((f32x2){v0[2], v0[3]}), o2 = act2<4>((f32x2){v1[0], v1[1]}), o3 = act2<4>((f32x2){v1[2], v1[3]});
                    u32x4 w; w.x = pk2(o0.x, o0.y); w.y = pk2(o1.x, o1.y); w.z = pk2(o2.x, o2.y); w.w = pk2(o3.x, o3.y);
                    *(u32x4*)(tb + (ai * 128 + m * 16) * 256 + bj * 128) = w;
                }
    }
    template <int MODE, bool ISU> __device__ __forceinline__ void run(const f32x4 (&acc)[2][2][4][2], const f32x4 (&bv)[2][2], const Unit& u, int wr, int wc, int fr, int fq, int colshift) const {
        const int row0 = u.pm * 256 + wr * 64 + fr, col0 = u.pn * 256 + wc * 32 + 8 * fq;
#pragma unroll
        for (int ai = 0; ai < 2; ++ai)
#pragma unroll
            for (int m = 0; m < 4; ++m) {
                const int row = row0 + ai * 128 + m * 16;
                bf16_t* rowp;
                if (ISU) {
                    int xsrow, s;
                    if (row < MX) { const int b = row >> 11, n = row & 2047; xsrow = b * 64 + (n >> 5); s = n & 31; }
                    else { const int mm = row - MX, b = mm >> 8, n = mm & 255; xsrow = 1024 + b * 8 + (n >> 5); s = n & 31; }
                    rowp = Xs + (size_t)xsrow * XS_K + s * 16;
                } else rowp = Z + (size_t)row * LDZ;
#pragma unroll
                for (int bj = 0; bj < 2; ++bj) {
                    const f32x4 v0 = acc[ai][bj][m][0] + bv[bj][0], v1 = acc[ai][bj][m][1] + bv[bj][1];
                    const f32x2 o0 = act2<MODE>((f32x2){v0[0], v0[1]}), o1 = act2<MODE>((f32x2){v0[2], v0[3]}), o2 = act2<MODE>((f32x2){v1[0], v1[1]}), o3 = act2<MODE>((f32x2){v1[2], v1[3]});
                    u32x4 w; w.x = pk2(o0.x, o0.y); w.y = pk2(o1.x, o1.y); w.z = pk2(o2.x, o2.y); w.w = pk2(o3.x, o3.y);
                    const int col = col0 + bj * 128 - colshift;
                    if (ISU) *(u32x4*)(rowp + (size_t)(col >> 4) * ((size_t)XS_ROWS * XS_K) + (col & 15)) = w;
                    else *(u32x4*)(rowp + col) = w;
                }
            }
    }
    __device__ __forceinline__ void load_bias(f32x4 (&bv)[2][2], const LAS unsigned char* bl, int wc, int fq) const {
#pragma unroll
        for (int bj = 0; bj < 2; ++bj)
#pragma unroll
            for (int n = 0; n < 2; ++n) bv[bj][n] = *(const LAS f32x4*)(bl + (wc * 32 + 8 * fq + bj * 128 + 4 * n) * 4);
    }
    __device__ __forceinline__ void operator()(const f32x4 (&acc)[2][2][4][2], const f32x4 (&bv)[2][2], const Unit& u, int wr, int wc, int fr, int fq) const {
        const int pn = u.pn;
        if (pn >= 16 && pn < 48) run_merge(acc, bv, u, wr, wc, fr, fq);
        else if (pn >= 8 && pn < 16) run<3, false>(acc, bv, u, wr, wc, fr, fq, 0);
        else if (pn >= 6 && pn < 8) run<2, false>(acc, bv, u, wr, wc, fr, fq, 0);
        else if (pn >= 4 && pn < 6) run<1, false>(acc, bv, u, wr, wc, fr, fq, 0);
        else if (pn < 2) run<0, true>(acc, bv, u, wr, wc, fr, fq, 0);
        else run<0, false>(acc, bv, u, wr, wc, fr, fq, pn >= 48 ? 12288 : 0);
    }
};
struct Epi1b {
    static constexpr bool PERM = true;
    bf16_t* Vt; bf16_t* vT; const float* bias;
    __device__ __forceinline__ void load_bias(f32x4 (&bv)[2][2], const LAS unsigned char* bl, int wr, int fr) const {
#pragma unroll
        for (int ai = 0; ai < 2; ++ai)
#pragma unroll
            for (int m = 0; m < 4; ++m) bv[ai][0][m] = *(const LAS float*)(bl + (wr * 64 + fr + ai * 128 + m * 16) * 4);
    }
    template <bool ISG> __device__ __forceinline__ void run(const f32x4 (&acc)[2][2][4][2], const f32x4 (&bv)[2][2], const Unit& u, int wr, int wc, int fr, int fq) const {
        const int f0 = u.pm * 256 + wr * 64 + fr, t0 = wc * 32 + 8 * fq;
        const int pn = u.pn;
#pragma unroll
        for (int ai = 0; ai < 2; ++ai)
#pragma unroll
            for (int m = 0; m < 4; ++m) {
                const int f = f0 + ai * 128 + m * 16; const float bf = bv[ai][0][m];
                bf16_t* rowp = (ISG ? vT + (size_t)(f - 512) * MT : Vt + (size_t)f * MT) + pn * 256;
#pragma unroll
                for (int bj = 0; bj < 2; ++bj) {
                    float o[8];
#pragma unroll
                    for (int j = 0; j < 8; ++j) { const float x = acc[ai][bj][m][j >> 2][j & 3] + bf; o[j] = ISG ? gelu_t(x) : x; }
                    u32x4 w; w.x = pk2(o[0], o[1]); w.y = pk2(o[2], o[3]); w.z = pk2(o[4], o[5]); w.w = pk2(o[6], o[7]);
                    *(u32x4*)(rowp + t0 + bj * 128) = w;
                }
            }
    }
    __device__ __forceinline__ void operator()(const f32x4 (&acc)[2][2][4][2], const f32x4 (&bv)[2][2], const Unit& u, int wr, int wc, int fr, int fq) const {
        if (u.pm >= 2) run<true>(acc, bv, u, wr, wc, fr, fq); else run<false>(acc, bv, u, wr, wc, fr, fq);
    }
};
struct Epi1ab {
    static constexpr bool PERM = true;
    static constexpr bool HAS_PRE = true;
    Epi1a a; Epi1b b;
    __device__ __forceinline__ void pre(const Unit& u, LAS unsigned char* lds, int wid, int lane, int sl) const {
        if (wid != 0) return;
        const float* src = (u.z == 0 ? a.bias + u.pn * 256 : b.bias + u.pm * 256) + lane * 4;
        __builtin_amdgcn_global_load_lds((const unsigned*)src, (LAS unsigned*)(lds + EPI_BIAS_LDS + sl * 1024), 16, 0, 0);
    }
    __device__ __forceinline__ void operator()(const f32x4 (&acc)[2][2][4][2], const Unit& u, int wr, int wc, int fr, int fq) const {
        f32x4 bv[2][2];
        const LAS unsigned char* bl = lds0 + EPI_BIAS_LDS + slot * 1024;
        if (u.z == 0) { a.load_bias(bv, bl, wc, fq); a(acc, bv, u, wr, wc, fr, fq); }
        else { bv[0][1] = (f32x4){0.f, 0.f, 0.f, 0.f}; bv[1][1] = bv[0][1]; b.load_bias(bv, bl, wr, fr); b(acc, bv, u, wr, wc, fr, fq); }
    }
    LAS unsigned char* lds0; int slot;
};
struct EpiB1 {
    static constexpr bool PERM = true;
    bf16_t* Ptx; bf16_t* Ptc;
    __device__ __forceinline__ void operator()(const f32x4 (&acc)[2][2][4][2], const Unit& u, int wr, int wc, int fr, int fq) const {
        const int f0 = u.pm * 256 + wr * 64 + fr, t0 = wc * 32 + 8 * fq;
        const int pn = u.pn;
#pragma unroll
        for (int ai = 0; ai < 2; ++ai)
#pragma unroll
            for (int m = 0; m < 4; ++m) {
                const int f = f0 + ai * 128 + m * 16;
                bf16_t* rowp;
                if (pn < 128) rowp = Ptx + ((size_t)((pn >> 3) * 1024 + f)) * 2048 + (pn & 7) * 256;
                else rowp = Ptc + ((size_t)((pn - 128) * 1024 + f)) * 256;
#pragma unroll
                for (int bj = 0; bj < 2; ++bj) {
                    const f32x4 v0 = acc[ai][bj][m][0], v1 = acc[ai][bj][m][1];
                    u32x4 w; w.x = pk2(v0[0], v0[1]); w.y = pk2(v0[2], v0[3]); w.z = pk2(v1[0], v1[1]); w.w = pk2(v1[2], v1[3]);
                    *(u32x4*)(rowp + t0 + bj * 128) = w;
                }
                asm volatile("" ::: "memory");
            }
    }
};
template <bool CTX> struct EpiFB2 {
    static constexpr bool PERM = true;
    bf16_t* Y; const bf16_t* Z; const float* bfn;
    __device__ __forceinline__ void operator()(const f32x4 (&acc)[2][2][4][2], const Unit& u, int wr, int wc, int fr, int fq) const {
        const int n0 = u.pm * 256 + wr * 64 + fr, cg0 = u.pn * 256 + wc * 32 + 8 * fq;
#pragma unroll
        for (int bj = 0; bj < 2; ++bj) {
            const int cg = cg0 + bj * 128, b = cg >> 9, col = cg & 511;
            const f32x4 b0 = *(const f32x4*)(bfn + col), b1 = *(const f32x4*)(bfn + col + 4);
#pragma unroll
            for (int ai = 0; ai < 2; ++ai)
#pragma unroll
                for (int m = 0; m < 4; ++m) {
                    const int n = n0 + ai * 128 + m * 16;
                    const size_t tok = CTX ? (size_t)(MX + b * CTXL + n) : (size_t)(b * SEQ + n);
                    const u32x4 gt = *(const u32x4*)(Z + tok * LDZ + ZC_GATE + 512 + col);
                    const f32x4 v0 = acc[ai][bj][m][0] + b0, v1 = acc[ai][bj][m][1] + b1;
                    u32x4 w; w.x = pk2(v0[0] * bflo(gt.x), v0[1] * bfhi(gt.x)); w.y = pk2(v0[2] * bflo(gt.y), v0[3] * bfhi(gt.y));
                    w.z = pk2(v1[0] * bflo(gt.z), v1[1] * bfhi(gt.z)); w.w = pk2(v1[2] * bflo(gt.w), v1[3] * bfhi(gt.w));
                    *(u32x4*)(Y + tok * DM + 512 + col) = w;
                    asm volatile("" ::: "memory");
                }
        }
    }
};
struct EpiS5E {
    static constexpr bool PERM = false;
    float* E;
    __device__ __forceinline__ void operator()(const f32x4 (&acc)[2][2][4][2], const Unit& u, int wr, int wc, int fr, int fq) const {
        const int row0 = u.pm * 256 + wr * 64 + fr, col0 = wc * 32 + 4 * fq;
#pragma unroll
        for (int ai = 0; ai < 2; ++ai)
#pragma unroll
            for (int m = 0; m < 4; ++m) {
                const int row = row0 + ai * 128 + m * 16;
                if (row < 1152) { float* rp = E + ((size_t)u.z * XS_ROWS + row) * 256 + col0;
#pragma unroll
                    for (int bj = 0; bj < 2; ++bj)
#pragma unroll
                        for (int n = 0; n < 2; ++n) *(f32x4*)(rp + bj * 128 + n * 16) = acc[ai][bj][m][n]; }
            }
    }
};
struct EpiS5Y {
    static constexpr bool PERM = true;
    bf16_t* Yd;
    __device__ __forceinline__ void operator()(const f32x4 (&acc)[2][2][4][2], const Unit& u, int wr, int wc, int fr, int fq) const {
        const int row0 = u.pm * 256 + wr * 64 + fr, cc0 = u.pn * 256 + wc * 32 + 8 * fq;
#pragma unroll
        for (int ai = 0; ai < 2; ++ai)
#pragma unroll
            for (int m = 0; m < 4; ++m) {
                const int row = row0 + ai * 128 + m * 16;
                if (row < 1152) {
                    int tokb;
                    if (row < 1024) tokb = (row >> 6) * SEQ + (row & 63) * 32; else { const int r2 = row - 1024; tokb = MX + (r2 >> 3) * CTXL + (r2 & 7) * 32; }
#pragma unroll
                    for (int bj = 0; bj < 2; ++bj) {
                        const int cc = cc0 + bj * 128, t = cc >> 4, hh = cc & 15;
                        float o[8];
#pragma unroll
                        for (int j = 0; j < 8; ++j) o[j] = gelu_t(acc[ai][bj][m][j >> 2][j & 3]);
                        u32x4 w; w.x = pk2(o[0], o[1]); w.y = pk2(o[2], o[3]); w.z = pk2(o[4], o[5]); w.w = pk2(o[6], o[7]);
                        *(u32x4*)(Yd + (size_t)(tokb + t) * 512 + u.z * 16 + hh) = w;
                    }
                }
            }
    }
};
struct EpiGLU {
    static constexpr bool PERM = true;
    bf16_t* Y; const bf16_t* Yd; const bf16_t* Z; const float* bg;
    __device__ __forceinline__ void operator()(const f32x4 (&acc)[2][2][4][2], const Unit& u, int wr, int wc, int fr, int fq) const {
        const int row0 = u.pm * 256 + wr * 64 + fr, col0 = u.pn * 256 + wc * 32 + 8 * fq;
#pragma unroll
        for (int bj = 0; bj < 2; ++bj) {
            const int col = col0 + bj * 128;
            const f32x4 b0 = *(const f32x4*)(bg + col), b1 = *(const f32x4*)(bg + col + 4);
#pragma unroll
            for (int ai = 0; ai < 2; ++ai)
#pragma unroll
                for (int m = 0; m < 4; ++m) {
                    const size_t tok = (size_t)(row0 + ai * 128 + m * 16);
                    const u32x4 yv = *(const u32x4*)(Yd + tok * 512 + col);
                    const u32x4 gt = *(const u32x4*)(Z + tok * LDZ + ZC_GATE + 1536 + col);
                    const f32x4 v0 = acc[ai][bj][m][0] + b0, v1 = acc[ai][bj][m][1] + b1;
                    u32x4 w;
                    w.x = pk2(bflo(yv.x) * sigm(v0[0]) * bflo(gt.x), bfhi(yv.x) * sigm(v0[1]) * bfhi(gt.x));
                    w.y = pk2(bflo(yv.y) * sigm(v0[2]) * bflo(gt.y), bfhi(yv.y) * sigm(v0[3]) * bfhi(gt.y));
                    w.z = pk2(bflo(yv.z) * sigm(v1[0]) * bflo(gt.z), bfhi(yv.z) * sigm(v1[1]) * bfhi(gt.z));
                    w.w = pk2(bflo(yv.w) * sigm(v1[2]) * bflo(gt.w), bfhi(yv.w) * sigm(v1[3]) * bfhi(gt.w));
                    *(u32x4*)(Y + tok * DM + 1536 + col) = w;
                    asm volatile("" ::: "memory");
                }
        }
    }
};
struct EpiUP {
    static constexpr bool PERM = true; static constexpr int NPRE = 2;
    bf16_t* Mo; const bf16_t* Z;
    f32x4 ms[2][4][2];
    u32x4 sg0[2];
    __device__ __forceinline__ void prefetch(const Unit& u, int wr, int wc, int fr, int fq) {
        const bf16_t* p = Z + ((size_t)((u.z * 144 + (u.pm >> 1)) * 8 + u.pn)) * 65536 + ((u.pm & 1) * 128 + wr * 64 + fr) * 256 + wc * 32 + 8 * fq;
#pragma unroll
        for (int m = 0; m < 2; ++m) sg0[m] = *(const u32x4*)(p + (m * 16) * 256);
    }
    __device__ __forceinline__ void operator()(const f32x4 (&acc)[2][4][2], const Unit& u, int wr, int wc, int fr, int fq) {
        const int row0 = u.pm * 128 + wr * 64 + fr, col0 = u.pn * 256 + wc * 32 + 8 * fq;
        const int i = u.z;
        u32x4 sg1[4], sg2[2];
        const bf16_t* tb = Z + ((size_t)((i * 144 + (u.pm >> 1)) * 8 + u.pn)) * 65536 + ((u.pm & 1) * 128 + wr * 64 + fr) * 256 + wc * 32 + 8 * fq;
#pragma unroll
        for (int m = 0; m < 2; ++m) sg2[m] = *(const u32x4*)(tb + ((m + 2) * 16) * 256);
#pragma unroll
        for (int m = 0; m < 4; ++m) sg1[m] = *(const u32x4*)(tb + (m * 16) * 256 + 128);
#pragma unroll
        for (int bj = 0; bj < 2; ++bj) {
            const int col = col0 + bj * 128;
#pragma unroll
            for (int m = 0; m < 4; ++m) {
                f32x4 t0 = acc[bj][m][0], t1 = acc[bj][m][1]; const u32x4 g4 = bj == 0 ? (m < 2 ? sg0[m & 1] : sg2[m & 1]) : sg1[m];
                t0[0] *= bflo(g4.x); t0[1] *= bfhi(g4.x); t0[2] *= bflo(g4.y); t0[3] *= bfhi(g4.y);
                t1[0] *= bflo(g4.z); t1[1] *= bfhi(g4.z); t1[2] *= bflo(g4.w); t1[3] *= bfhi(g4.w);
                if (i > 0) { t0 += ms[bj][m][0]; t1 += ms[bj][m][1]; }
                ms[bj][m][0] = t0; ms[bj][m][1] = t1;
                if (i == 3) { u32x4 w; w.x = pk2(t0[0], t0[1]); w.y = pk2(t0[2], t0[3]); w.z = pk2(t1[0], t1[1]); w.w = pk2(t1[2], t1[3]);
                    *(u32x4*)(Mo + (size_t)(row0 + m * 16) * DM + col) = w; }
            }
        }
    }
};
constexpr int EPI_OUT_LDS = EPI_BIAS_LDS + 2048;
struct EpiOUT {
    static constexpr bool PERM = false;
    static constexpr bool HAS_PRE = true;
    const float* xsrc; const float* csrc; float* xdst; float* cdst; const float* ada;
    const float* gp; const float* bp; const float* rsp; bool first;
    LAS unsigned char* lds0; int slot;
    __device__ __forceinline__ void pre(const Unit& u, LAS unsigned char* lds, int wid, int lane, int sl) const {
        if (wid >= 3) return;
        const int bidx = u.pm < 128 ? (u.pm >> 3) : 16;
        const float* src = (wid == 0 ? ada + (size_t)bidx * 6144 + 4096 : (wid == 1 ? gp : bp)) + u.pn * 256 + lane * 4;
        __builtin_amdgcn_global_load_lds((const unsigned*)src, (LAS unsigned*)(lds + EPI_OUT_LDS + sl * 3072 + wid * 1024), 16, 0, 0);
    }
    __device__ __forceinline__ void operator()(f32x4 (&acc)[2][2][4][2], const Unit& u, int wr, int wc, int fr, int fq) const {
        const bool isx = u.pm < 128;
        const float* src = isx ? xsrc : csrc - (size_t)MX * DM; float* dst = isx ? xdst : cdst - (size_t)MX * DM;
        const int row0 = u.pm * 256 + wr * 64 + fr, col0 = u.pn * 256 + wc * 32 + 4 * fq;
        const LAS unsigned char* vl = lds0 + EPI_OUT_LDS + slot * 3072 + (wc * 32 + 4 * fq) * 4;
        f32x4 xv[3][2][2]; f32x2 st[3];
#define EPO_ISSUE(g) do { const int row = row0 + ((g) >> 2) * 128 + ((g) & 3) * 16; const size_t off = (size_t)row * DM + col0; \
            { const f32x2 t_ = *(const f32x2*)(rsp + (size_t)row * 2); st[(g) % 3].x = first ? 0.f : t_.x; st[(g) % 3].y = first ? 1.f : t_.y; }        \
            _Pragma("unroll") for (int bj = 0; bj < 2; ++bj) _Pragma("unroll") for (int n = 0; n < 2; ++n) xv[(g) % 3][bj][n] = *(const f32x4*)(src + off + bj * 128 + n * 16); } while (0)
        EPO_ISSUE(0); EPO_ISSUE(1); EPO_ISSUE(2);
        asm volatile("" ::: "memory");
#pragma unroll
        for (int bj = 0; bj < 2; ++bj)
#pragma unroll
            for (int n = 0; n < 2; ++n) {
                const f32x4 gvv = *(const LAS f32x4*)(vl + bj * 512 + n * 64);
                const f32x4 bpp = *(const LAS f32x4*)(vl + 2048 + bj * 512 + n * 64) * (first ? 0.f : DN_ALPHA);
#pragma unroll
                for (int ai = 0; ai < 2; ++ai)
#pragma unroll
                    for (int m = 0; m < 4; ++m) acc[ai][bj][m][n] = gvv * acc[ai][bj][m][n] + bpp;
            }
        f32x4 gpv[2][2];
#pragma unroll
        for (int bj = 0; bj < 2; ++bj)
#pragma unroll
            for (int n = 0; n < 2; ++n) { const f32x4 t = *(const LAS f32x4*)(vl + 1024 + bj * 512 + n * 64);
#pragma unroll
                for (int e = 0; e < 4; ++e) gpv[bj][n][e] = first ? DN_ALPHA : t[e] * DN_ALPHA; }
#pragma unroll
        for (int g = 0; g < 8; ++g) {
            const int ai = g >> 2, m = g & 3;
            const int row = row0 + ai * 128 + m * 16; const size_t off = (size_t)row * DM + col0;
            const float mu = st[g % 3].x, ar = st[g % 3].y;
#pragma unroll
            for (int bj = 0; bj < 2; ++bj)
#pragma unroll
                for (int n = 0; n < 2; ++n) *(f32x4*)(dst + off + bj * 128 + n * 16) = (xv[g % 3][bj][n] - mu) * ar * gpv[bj][n] + acc[ai][bj][m][n];
            asm volatile("" ::: "memory");
            if (g + 3 < 8) { EPO_ISSUE(g + 3); asm volatile("" ::: "memory"); }
        }
#undef EPO_ISSUE
    }
};

struct EpiOUTh {
    static constexpr bool PERM = false;
    EpiOUT e;
    __device__ __forceinline__ void operator()(const f32x4 (&acc)[2][4][2], const Unit& u, int wr, int wc, int fr, int fq) {
        const bool isx = u.pm < 128;
        const int bidx = isx ? (u.pm >> 3) : 16;
        const float* src = isx ? e.xsrc : e.csrc - (size_t)MX * DM; float* dst = isx ? e.xdst : e.cdst - (size_t)MX * DM;
        const int row0 = u.pm * 256 + wr * 64 + fr, col0 = u.pn * 128 + wc * 32 + 4 * fq;
        f32x4 gv[2], gpv[2], bpv[2];
#pragma unroll
        for (int n = 0; n < 2; ++n) { const int c = col0 + n * 16;
            gv[n] = *(const f32x4*)(e.ada + (size_t)bidx * 6144 + 4096 + c);
            { const f32x4 tg = *(const f32x4*)(e.gp + c), tb = *(const f32x4*)(e.bp + c); const float ka = e.first ? 0.f : DN_ALPHA, kc = e.first ? DN_ALPHA : 0.f; gpv[n] = tg * ka + kc; bpv[n] = tb * ka; } }
        f32x4 xv[2][4][2]; f32x2 st[2][4];
#pragma unroll
        for (int ai = 0; ai < 2; ++ai)
#pragma unroll
            for (int m = 0; m < 4; ++m) {
                const int row = row0 + ai * 128 + m * 16; const size_t off = (size_t)row * DM + col0;
                const f32x2 t = *(const f32x2*)(e.rsp + (size_t)row * 2); st[ai][m].x = e.first ? 0.f : t.x; st[ai][m].y = e.first ? 1.f : t.y;
#pragma unroll
                for (int n = 0; n < 2; ++n) xv[ai][m][n] = *(const f32x4*)(src + off + n * 16);
            }
        asm volatile("" ::: "memory");
#pragma unroll
        for (int ai = 0; ai < 2; ++ai)
#pragma unroll
            for (int m = 0; m < 4; ++m) {
                const int row = row0 + ai * 128 + m * 16; const size_t off = (size_t)row * DM + col0;
                const float mu = st[ai][m].x, ar = st[ai][m].y;
#pragma unroll
                for (int n = 0; n < 2; ++n) *(f32x4*)(dst + off + n * 16) = (xv[ai][m][n] - mu) * ar * gpv[n] + bpv[n] + gv[n] * acc[ai][m][n];
            }
    }
};

__device__ __forceinline__ void transpose_item(const float* W, int ldw, int c0, int k0, bf16_t* WT, int K, int r0, LAS float* scr, int lane) {
    float tv[32];
#pragma unroll
    for (int i = 0; i < 32; ++i) tv[i] = W[(size_t)(k0 + 2 * i + (lane >> 5)) * ldw + c0 + (lane & 31)];
#pragma unroll
    for (int i = 0; i < 32; ++i) scr[(2 * i + (lane >> 5)) * 33 + (lane & 31)] = tv[i];
    LDS_WAIT(); asm volatile("" ::: "memory");
    const int c = lane & 7;
#pragma unroll
    for (int j = 0; j < 4; ++j) { const int n = (lane >> 3) + 8 * j; const LAS float* s = scr + (8 * c) * 33 + n;
        u32x4 o; o.x = pk2(s[0 * 33], s[1 * 33]); o.y = pk2(s[2 * 33], s[3 * 33]); o.z = pk2(s[4 * 33], s[5 * 33]); o.w = pk2(s[6 * 33], s[7 * 33]);
        *(u32x4*)(WT + (size_t)(r0 + n) * K + k0 + 8 * c) = o; }
    LDS_WAIT(); asm volatile("" ::: "memory");
}
__device__ __forceinline__ int win_src_col(int j) {
    if (j < 1024) return j;
    if (j < 1536) return OFF_C_Q + (j - 1024);
    if (j < 2048) return OFF_A_UV + (j - 1536);
    if (j < 4096) return OFF_GATE + (j - 2048);
    if (j < 12288) return OFF_MERGE + (j - 4096);
    return OFF_B + (j - 12288);
}
__device__ __forceinline__ float hw_sin_rev(float rev) { return __builtin_amdgcn_sinf(rev); }
__device__ __forceinline__ float hw_cos_rev(float rev) { return __builtin_amdgcn_cosf(rev); }

__device__ __forceinline__ void s5_setup_unit(Frame& F, int l, int uidx) {
    const int par = l & 1, g = uidx >> 2, q = uidx & 3;
    LAS float* pw = (LAS float*)(F.lds);
    LAS float* bb = (LAS float*)(F.lds + 33792);
    LAS float* cc = (LAS float*)(F.lds + 50176);
    LAS float* kt = (LAS float*)(F.lds + 66560);
    const float* a_re = F.in[F.zi + I_ARE] + (size_t)l * 2 * 32 * 64, *a_im = F.in[F.zi + I_AIM] + (size_t)l * 2 * 32 * 64, *ldt = F.in[F.zi + I_LOGDT] + (size_t)l * 2 * 32;
    const float* b_re = F.in[F.zi + I_BRE] + (size_t)l * 2 * 32 * 64 * 16, *b_im = F.in[F.zi + I_BIM] + (size_t)l * 2 * 32 * 64 * 16;
    const float* c_re = F.in[F.zi + I_CRE] + (size_t)l * 2 * 32 * 16 * 64, *c_im = F.in[F.zi + I_CIM] + (size_t)l * 2 * 32 * 16 * 64;
    const float* dsk = F.in[F.zi + I_S5D] + (size_t)l * 512 + g * 16;
    float* AT = (float*)(F.ws + WS_AT + (size_t)par * AT_STRIDE);
    LAS float* dsl = (LAS float*)(F.lds + 132096);
    if (F.tid < 16) dsl[F.tid] = dsk[F.tid];
    float lr2[2], li2[2];
#pragma unroll
    for (int d = 0; d < 2; ++d) { const float dt = expf(ldt[d * 32 + g]); const int p = F.tid & 63; lr2[d] = a_re[(d * 32 + g) * 64 + p] * dt; li2[d] = a_im[(d * 32 + g) * 64 + p] * dt; }
    for (int it = F.tid; it < 2 * 64 * 33; it += 512) {
        const int d = it / (64 * 33), r = it % (64 * 33), j = r / 64, p = r % 64;
        const float lr = d == 0 ? lr2[0] : lr2[1], li = d == 0 ? li2[0] : li2[1];
        const float mag = expf((float)j * lr);
        double rev = (double)j * (double)li * 0.15915494309189535; rev -= rint(rev);
        const float cr = hw_cos_rev((float)rev), sr = hw_sin_rev((float)rev);
        pw[((d * 33 + j) * 64 + p) * 2 + 0] = mag * cr; pw[((d * 33 + j) * 64 + p) * 2 + 1] = mag * sr;
        if (j == 32 && q == 0) { AT[((g * 2 + d) * 64 + p) * 2 + 0] = mag * cr; AT[((g * 2 + d) * 64 + p) * 2 + 1] = mag * sr; }
    }
    for (int it = F.tid; it < 2 * 64 * 16; it += 512) {
        const int d = it / 1024, r = it % 1024, p = r / 16, h = r % 16;
        const float dt = expf(ldt[d * 32 + g]);
        const float are = a_re[(d * 32 + g) * 64 + p], aim = a_im[(d * 32 + g) * 64 + p];
        const float lr = are * dt, li = aim * dt;
        const float mag = expf(lr);
        double rev = (double)li * 0.15915494309189535; rev -= rint(rev);
        const float abr = mag * hw_cos_rev((float)rev), abi = mag * hw_sin_rev((float)rev);
        const float den = are * are + aim * aim;
        const float fre = ((abr - 1.0f) * are + abi * aim) / den, fim = (abi * are - (abr - 1.0f) * aim) / den;
        const float bre = b_re[((size_t)(d * 32 + g) * 64 + p) * 16 + h], bim = b_im[((size_t)(d * 32 + g) * 64 + p) * 16 + h];
        bb[it * 2 + 0] = fre * bre - fim * bim; bb[it * 2 + 1] = fre * bim + fim * bre;
    }
    for (int it = F.tid; it < 2 * 16 * 64; it += 512) {
        const int d = it / 1024, r = it % 1024, hp = r / 64, p = r % 64;
        cc[((d * 64 + p) * 16 + hp) * 2 + 0] = c_re[((size_t)(d * 32 + g) * 16 + hp) * 64 + p]; cc[((d * 64 + p) * 16 + hp) * 2 + 1] = c_im[((size_t)(d * 32 + g) * 16 + hp) * 64 + p];
    }
    __syncthreads();
    for (int it = F.tid; it < 2 * 32 * 16; it += 512) {
        const int d = it / 512, r = it % 512, j = r / 16, hp = r % 16;
        float sacc[16];
#pragma unroll
        for (int h = 0; h < 16; ++h) sacc[h] = 0.f;
#pragma unroll 2
        for (int p = 0; p < 64; ++p) {
            const f32x2 pv = *(const LAS f32x2*)(pw + ((d * 33 + j) * 64 + p) * 2), cv = *(const LAS f32x2*)(cc + ((d * 64 + p) * 16 + hp) * 2);
            const float wr_ = cv.x * pv.x - cv.y * pv.y, wi_ = cv.x * pv.y + cv.y * pv.x;
            const LAS f32x4* bp = (const LAS f32x4*)(bb + ((d * 64 + p) * 16) * 2);
#pragma unroll
            for (int h2 = 0; h2 < 8; ++h2) { const f32x4 b2 = bp[h2]; sacc[2 * h2] += wr_ * b2.x - wi_ * b2.y; sacc[2 * h2 + 1] += wr_ * b2.z - wi_ * b2.w; }
        }
#pragma unroll
        for (int h = 0; h < 16; ++h) kt[(d * 32 + j) * 256 + hp * 16 + h] = sacc[h];
    }
    __syncthreads();
    bf16_t* W3 = (bf16_t*)(F.ws + WS_W3 + (size_t)par * W3_STRIDE) + (size_t)g * 512 * 768;
    for (int it = F.tid; it < 128 * 96; it += 512) {
        const int row = 128 * q + it / 96, k0 = (it % 96) * 8, t = row >> 4, hp = row & 15;
        float v[8];
        if (k0 < 512) { const int s_ = k0 >> 4, h0 = k0 & 15;
#pragma unroll
            for (int e = 0; e < 8; ++e) v[e] = 0.f;
            if (s_ <= t) { const LAS f32x4* kp = (const LAS f32x4*)(kt + (0 * 32 + (t - s_)) * 256 + hp * 16 + h0); const f32x4 a0 = kp[0], a1 = kp[1];
                v[0] += a0[0]; v[1] += a0[1]; v[2] += a0[2]; v[3] += a0[3]; v[4] += a1[0]; v[5] += a1[1]; v[6] += a1[2]; v[7] += a1[3]; }
            if (s_ >= t) { const LAS f32x4* kp = (const LAS f32x4*)(kt + (1 * 32 + (s_ - t)) * 256 + hp * 16 + h0); const f32x4 a0 = kp[0], a1 = kp[1];
                v[0] += a0[0]; v[1] += a0[1]; v[2] += a0[2]; v[3] += a0[3]; v[4] += a1[0]; v[5] += a1[1]; v[6] += a1[2]; v[7] += a1[3]; }
            if (s_ == t) { const float dv = dsl[hp];
#pragma unroll
                for (int e = 0; e < 8; ++e) v[e] += (h0 + e == hp) ? dv : 0.f; }
        } else { const int d = (k0 - 512) >> 7, ri = ((k0 - 512) >> 6) & 1, p0 = k0 & 63;
            const int j = d == 0 ? (t + 1) : (32 - t);
#pragma unroll
            for (int e = 0; e < 8; ++e) { const int p = p0 + e;
                const f32x2 pv = *(const LAS f32x2*)(pw + ((d * 33 + j) * 64 + p) * 2), cv = *(const LAS f32x2*)(cc + ((d * 64 + p) * 16 + hp) * 2);
                v[e] = ri == 0 ? (cv.x * pv.x - cv.y * pv.y) : -(cv.x * pv.y + cv.y * pv.x); }
        }
        u32x4 o; o.x = pk2(v[0], v[1]); o.y = pk2(v[2], v[3]); o.z = pk2(v[4], v[5]); o.w = pk2(v[6], v[7]);
        *(u32x4*)(W3 + (size_t)row * 768 + k0) = o;
    }
    bf16_t* Me = (bf16_t*)(F.ws + (par ? WS_MEND2 : WS_MEND)) + (size_t)g * 256 * 512;
    for (int it = F.tid; it < 64 * 64; it += 512) {
        const int row = 64 * q + it / 64, k0 = (it % 64) * 8, d = row >> 7, ri = (row >> 6) & 1, p = row & 63;
        const int s_ = k0 >> 4, h0 = k0 & 15, j = d == 0 ? (31 - s_) : s_;
        const f32x2 pv = *(const LAS f32x2*)(pw + ((d * 33 + j) * 64 + p) * 2);
        float v[8];
#pragma unroll
        for (int e = 0; e < 8; ++e) { const f32x2 bv = *(const LAS f32x2*)(bb + ((d * 64 + p) * 16 + h0 + e) * 2);
            v[e] = ri == 0 ? (pv.x * bv.x - pv.y * bv.y) : (pv.x * bv.y + pv.y * bv.x); }
        u32x4 o; o.x = pk2(v[0], v[1]); o.y = pk2(v[2], v[3]); o.z = pk2(v[4], v[5]); o.w = pk2(v[6], v[7]);
        *(u32x4*)(Me + (size_t)row * 512 + k0) = o;
    }
    __syncthreads();
}
__device__ __forceinline__ void fourier_setup_unit(Frame& F, int l, int uidx) {
    const int g = uidx >> 3, cs = (uidx >> 2) & 1, dq = uidx & 3;
    LAS float* tr = (LAS float*)(F.lds);
    const float* wf = F.in[F.zi + I_WFNET] + ((size_t)l * 4 + g) * 128 * 128;
    if (F.tid < 128) { const float rev = (float)F.tid * (1.0f / 128.0f); tr[F.tid] = (cs == 0 ? hw_cos_rev(rev) : hw_sin_rev(rev)) * 0.08838834764831845f; }
    LAS float* wl = (LAS float*)(F.lds + 1024);
#pragma unroll
    for (int e8 = 0; e8 < 8; ++e8) { const int e = F.tid + 512 * e8; wl[e] = wf[(e >> 5) * 128 + 32 * dq + (e & 31)]; }
    __syncthreads();
    bf16_t* WfT = (bf16_t*)(F.ws + ((l & 1) ? WS_WFT2 : WS_WFT));
    for (int it = F.tid; it < 32 * 64; it += 512) {
        const int d = 32 * dq + (it >> 6), c0 = (it & 63) * 2; float s0 = 0.f, s1 = 0.f;
#pragma unroll 4
        for (int dp = 0; dp < 128; ++dp) { const float w = wl[dp * 32 + (it >> 6)]; s0 += tr[(dp * c0) & 127] * w; s1 += tr[(dp * (c0 + 1)) & 127] * w; }
        bf16_t* row = WfT + (size_t)((g * 128 + d) * 2 + cs) * 512;
#pragma unroll
        for (int gp = 0; gp < 4; ++gp) *(unsigned*)(row + gp * 128 + c0) = (gp == g) ? pk2(s0, s1) : 0u;
    }
    __syncthreads();
}
__device__ __forceinline__ void setup_layer(Frame& F, int l, int ub, int nb) {
    const int par = l & 1, rb = F.bid - ub;
    __syncthreads();
    { if (rb < 128) s5_setup_unit(F, l, rb);
      else if (rb < 160) fourier_setup_unit(F, l, rb - 128); }
    LAS float* scr = (LAS float*)(F.lds + F.wave * 16384);
    const int gw = rb * 8 + F.wave, NGW = nb * 8;
    const float* win = F.in[F.zi + I_WIN] + (size_t)l * DM * IN_COLS;
    bf16_t* Wi = (bf16_t*)(F.ws + (par ? WS_WIN2 : WS_WIN)); bf16_t* Ws = (bf16_t*)(F.ws + (par ? WS_WSW2 : WS_WSW));
    constexpr int I_A = 32 * (N1A / 32), I_V = 32 * 16, I_S = 32 * 16, I_UP = 4 * 8 * 64, I_O = 32 * 64, I_G = 8 * 16;
    constexpr int NIT = I_A + I_V + I_S + I_UP + I_O + I_G;
    for (int it = gw; it < NIT; it += NGW) {
        int r = it;
        if (r < I_A) { const int kb = r / (N1A / 32), nb2 = r % (N1A / 32); transpose_item(win, IN_COLS, win_src_col(nb2 * 32), kb * 64, Wi, DM, nb2 * 32, scr, F.lane); continue; } r -= I_A;
        if (r < I_V) { const int kb = r / 16, nb2 = r % 16; transpose_item(win, IN_COLS, OFF_C_V + nb2 * 32, kb * 64, Ws, DM, nb2 * 32, scr, F.lane); continue; } r -= I_V;
        if (r < I_S) { const int kb = r / 16, nb2 = r % 16; transpose_item(win, IN_COLS, OFF_A_UV + 512 + nb2 * 32, kb * 64, Ws, DM, 512 + nb2 * 32, scr, F.lane); continue; } r -= I_S;
        if (r < I_UP) { const int i = r / 512, rr = r % 512, kb = rr / 64, nb2 = rr % 64;
            transpose_item(F.in[F.zi + I_WUP] + ((size_t)l * 4 + i) * 512 * DM, DM, nb2 * 32, kb * 64, (bf16_t*)(F.ws + WS_WUP + (size_t)par * WUP_STRIDE) + (size_t)i * DM * 512, 512, nb2 * 32, scr, F.lane); continue; } r -= I_UP;
        if (r < I_O) { const int kb = r / 64, nb2 = r % 64; transpose_item(F.in[F.zi + I_WO] + (size_t)l * DM * DM, DM, nb2 * 32, kb * 64, (bf16_t*)(F.ws + WS_WO + (size_t)par * WO_STRIDE), DM, nb2 * 32, scr, F.lane); continue; } r -= I_O;
        { const int kb = r / 16, nb2 = r % 16; transpose_item(F.in[F.zi + I_WGLU] + (size_t)l * 512 * 512, 512, nb2 * 32, kb * 64, (bf16_t*)(F.ws + WS_WGLU + (size_t)par * WGLU_STRIDE), 512, nb2 * 32, scr, F.lane); }
    }
    const int gt = rb * 512 + F.tid, NGT = nb * 512;
    const float* bin = F.in[F.zi + I_BIN] + (size_t)l * IN_COLS;
    float* b1a = (float*)(F.ws + WS_BIAS1A + (size_t)par * SMALL_STRIDE); float* b1b = (float*)(F.ws + WS_BIAS1B + (size_t)par * SMALL_STRIDE);
    for (int j = gt; j < N1A; j += NGT) b1a[j] = bin[win_src_col(j)];
    for (int j = gt; j < 512; j += NGT) { b1b[j] = bin[OFF_C_V + j]; b1b[512 + j] = bin[OFF_A_UV + 512 + j]; }
    const float* wsg = F.in[F.zi + I_WSGU] + (size_t)l * 4 * 128 * 128; bf16_t* wsb = (bf16_t*)(F.ws + WS_WSGU + (size_t)par * SMALL_STRIDE);
    for (int j = gt; j < 4 * 128 * 64; j += NGT) *(unsigned*)(wsb + 2 * j) = pk2(wsg[2 * j], wsg[2 * j + 1]);
}
__device__ __forceinline__ void prologue_a(Frame& F) {
    const int gw = F.bid * 8 + F.wave, NGW = F.G * 8;
    LAS float* sl = (LAS float*)(F.lds + F.wave * 16384);
    float* part = (float*)(F.ws + WS_ADAP);
    for (int it = gw; it < 4 * 24 * 16; it += NGW) {
        const int l = it / 384, r = it % 384, cg = r / 16, kp = r % 16;
        int ln = F.lane; asm volatile("" : "+v"(ln));
        { const float* cp = F.in[F.zi + I_C] + kp * 128 + ln; const float* xp = F.in[F.zi + I_CCTX] + kp * 128 + ln;
          float cv[34];
#pragma unroll
          for (int i = 0; i < 34; ++i) cv[i] = i < 32 ? cp[(i >> 1) * DM + (i & 1) * 64] : xp[(i & 1) * 64];
#pragma unroll
          for (int i = 0; i < 34; ++i) sl[ln + 64 * i] = silu_f(cv[i]); }
        LDS_WAIT(); asm volatile("" ::: "memory");
        const char* wb = (const char*)(F.in[F.zi + I_WADA] + (size_t)l * DM * 6144 + (size_t)(kp * 128) * 6144 + cg * 256) + ln * 16;
        f32x4 a[17];
#pragma unroll
        for (int q = 0; q < 17; ++q) a[q] = (f32x4){0.f, 0.f, 0.f, 0.f};
#pragma unroll 1
        for (int k0 = 0; k0 < 128; k0 += 8) {
            f32x4 wv[8];
#pragma unroll
            for (int j = 0; j < 8; ++j) wv[j] = *(const f32x4*)(wb + (size_t)(k0 + j) * (6144 * 4));
#pragma unroll
            for (int j4 = 0; j4 < 8; j4 += 4) {
#pragma unroll
                for (int q = 0; q < 17; ++q) { const f32x4 sv = *(const LAS f32x4*)(sl + q * 128 + k0 + j4);
                    a[q] += sv[0] * wv[j4]; a[q] += sv[1] * wv[j4 + 1]; a[q] += sv[2] * wv[j4 + 2]; a[q] += sv[3] * wv[j4 + 3]; }
                asm volatile("" ::: "memory");
            }
        }
#pragma unroll
        for (int q = 0; q < 17; ++q) *(f32x4*)(part + (((size_t)l * 16 + kp) * 17 + q) * 6144 + cg * 256 + ln * 4) = a[q];
        LDS_WAIT(); asm volatile("" ::: "memory");
    }
    bf16_t* dft = (bf16_t*)(F.ws + WS_DFT); bf16_t* dft2 = (bf16_t*)(F.ws + WS_DFT256);
    for (int n = gw; n < 2048 + 256; n += NGW) {
        if (n < 2048) { bf16_t* row = dft + (size_t)n * 4096;
            for (int k2 = F.lane; k2 < 2048; k2 += 64) { const int k = 2 * k2; float v[2];
#pragma unroll
                for (int e = 0; e < 2; ++e) { const int kk = k + e, np = kk & 2047; const float rev = (float)((n * np) & 2047) * (1.0f / 2048.0f);
                    v[e] = (kk < 2048 ? hw_cos_rev(rev) : -hw_sin_rev(rev)) * 0.022097086912079608f; }
                *(unsigned*)(row + k) = pk2(v[0], v[1]); }
        } else { const int nn = n - 2048; bf16_t* row = dft2 + (size_t)nn * 512;
            for (int k2 = F.lane; k2 < 256; k2 += 64) { const int k = 2 * k2; float v[2];
#pragma unroll
                for (int e = 0; e < 2; ++e) { const int kk = k + e, np = kk & 255; const float rev = (float)((nn * np) & 255) * (1.0f / 256.0f);
                    v[e] = (kk < 256 ? hw_cos_rev(rev) : -hw_sin_rev(rev)) * 0.0625f; }
                *(unsigned*)(row + k) = pk2(v[0], v[1]); }
        }
    }
}
__device__ __forceinline__ void ada_reduce(Frame& F) {
    const int gt = F.bid * 512 + F.tid, NGT = F.G * 512;
    const float* part = (const float*)(F.ws + WS_ADAP); float* ada = (float*)(F.ws + WS_ADA);
    for (int e = gt; e < 4 * 17 * 6144; e += NGT) {
        const int l = e / (17 * 6144), r = e % (17 * 6144), j = r % 6144;
        float s = F.in[F.zi + I_BADA][l * 6144 + j];
#pragma unroll
        for (int kp = 0; kp < 16; ++kp) s += part[((size_t)l * 16 + kp) * 17 * 6144 + r];
        ada[e] = s;
    }
}

__device__ __forceinline__ void ln_phase(Frame& F, int mode, const float* xin, const float* cin, float* xr, float* cr, const float* lng, const float* lnb, const float* adaN, int nrows) {
    const int gw = F.bid * 8 + F.wave, NGW = F.G * 8;
    bf16_t* H = (bf16_t*)(F.ws + WS_H);
    for (int row = gw; row < nrows; row += NGW) {
        const bool isx = row < MX; const int bidx = isx ? (row >> 11) : 16;
        f32x4 v[8];
        if (mode == 0) { const f32x4* s = (const f32x4*)((isx ? xin + (size_t)row * DM : cin + (size_t)(row - MX) * DM)) + F.lane;
#pragma unroll
            for (int j = 0; j < 8; ++j) v[j] = s[64 * j];
        } else {
            f32x4* s = (f32x4*)((isx ? xr + (size_t)row * DM : cr + (size_t)(row - MX) * DM)) + F.lane;
            float sm = 0.f;
#pragma unroll
            for (int j = 0; j < 8; ++j) { v[j] = s[64 * j]; sm += (v[j][0] + v[j][1]) + (v[j][2] + v[j][3]); }
            const float mean = wave_sum(sm, F.lane) * (1.0f / DM); float q = 0.f;
#pragma unroll
            for (int j = 0; j < 8; ++j) { v[j] = v[j] - mean; q += (v[j][0] * v[j][0] + v[j][1] * v[j][1]) + (v[j][2] * v[j][2] + v[j][3] * v[j][3]); }
            const float rstd = 1.0f / sqrtf(wave_sum(q, F.lane) * (1.0f / DM) + LN_EPS);
#pragma unroll
            for (int j = 0; j < 8; ++j) { const f32x4 gg = *((const f32x4*)lng + F.lane + 64 * j), bb = *((const f32x4*)lnb + F.lane + 64 * j); v[j] = v[j] * rstd * gg + bb; s[64 * j] = v[j]; }
        }
        if (adaN) {
            float sm = 0.f;
#pragma unroll
            for (int j = 0; j < 8; ++j) sm += (v[j][0] + v[j][1]) + (v[j][2] + v[j][3]);
            const float mean = wave_sum(sm, F.lane) * (1.0f / DM); float q = 0.f;
#pragma unroll
            for (int j = 0; j < 8; ++j) { v[j] = v[j] - mean; q += (v[j][0] * v[j][0] + v[j][1] * v[j][1]) + (v[j][2] * v[j][2] + v[j][3] * v[j][3]); }
            const float rstd = 1.0f / sqrtf(wave_sum(q, F.lane) * (1.0f / DM) + LN_EPS);
            const f32x4* sh = (const f32x4*)(adaN + (size_t)bidx * 6144) + F.lane; const f32x4* sc = (const f32x4*)(adaN + (size_t)bidx * 6144 + 2048) + F.lane;
            u32x2* o = (u32x2*)(H + (size_t)row * DM) + F.lane;
#pragma unroll
            for (int j = 0; j < 8; ++j) { const f32x4 a = sh[64 * j], b = sc[64 * j]; const f32x4 h = v[j] * rstd * (b + 1.0f) + a; u32x2 w; w.x = pk2(h[0], h[1]); w.y = pk2(h[2], h[3]); o[64 * j] = w; }
        }
    }
}

__device__ __forceinline__ void ln2_phase(Frame& F, float* xr, float* cr, const float* lng, const float* lnb, const float* adaN, int nrows) {
    const int gw = F.bid * 8 + F.wave, NGW = F.G * 8, lane = F.lane;
    bf16_t* H = (bf16_t*)(F.ws + WS_H); float* RS = (float*)(F.ws + WS_RS);
    const int RW = nrows / NGW, row0 = gw * RW;
    f32x4 gg[8], bb[8], sh[8], sc[8];
#pragma unroll
    for (int j = 0; j < 8; ++j) { gg[j] = *((const f32x4*)lng + lane + 64 * j); bb[j] = *((const f32x4*)lnb + lane + 64 * j); sh[j] = gg[j]; sc[j] = gg[j]; }
    int curb = -1;
    f32x4 vn[8];
    { const f32x4* s0 = (const f32x4*)((row0 < MX ? xr + (size_t)row0 * DM : cr + (size_t)(row0 - MX) * DM)) + lane;
#pragma unroll
      for (int j = 0; j < 8; ++j) vn[j] = s0[64 * j]; }
    for (int i = 0; i < RW; ++i) {
        const int row = row0 + i;
        const bool isx = row < MX; const int bidx = isx ? (row >> 11) : 16;
        f32x4* s = (f32x4*)((isx ? xr + (size_t)row * DM : cr + (size_t)(row - MX) * DM)) + lane;
        f32x4 v[8]; float sm = 0.f;
#pragma unroll
        for (int j = 0; j < 8; ++j) { v[j] = vn[j]; sm += (v[j][0] + v[j][1]) + (v[j][2] + v[j][3]); }
        if (i + 1 < RW) { const int rn = row + 1;
            const f32x4* sn = (const f32x4*)((rn < MX ? xr + (size_t)rn * DM : cr + (size_t)(rn - MX) * DM)) + lane;
#pragma unroll
            for (int j = 0; j < 8; ++j) vn[j] = sn[64 * j]; }
        if (adaN != nullptr && bidx != curb) { curb = bidx;
            const f32x4* shp = (const f32x4*)(adaN + (size_t)bidx * 6144) + lane; const f32x4* scp = (const f32x4*)(adaN + (size_t)bidx * 6144 + 2048) + lane;
#pragma unroll
            for (int j = 0; j < 8; ++j) { sh[j] = shp[64 * j]; sc[j] = scp[64 * j] + 1.0f; } }
        const float mu = wave_sum(sm, lane) * (1.0f / DM); float q = 0.f;
#pragma unroll
        for (int j = 0; j < 8; ++j) { v[j] = v[j] - mu; q += (v[j][0] * v[j][0] + v[j][1] * v[j][1]) + (v[j][2] * v[j][2] + v[j][3] * v[j][3]); }
        const float ar = 1.0f / sqrtf(wave_sum(q, lane) * (1.0f / DM) + LN_EPS);
#pragma unroll
        for (int j = 0; j < 8; ++j) v[j] = v[j] * ar * gg[j] + bb[j];
        if (adaN == nullptr) {
#pragma unroll
            for (int j = 0; j < 8; ++j) s[64 * j] = v[j];
        } else {
            if (lane == 0) *(f32x2*)(RS + (size_t)row * 2) = (f32x2){mu, ar};
            float sm2 = 0.f;
#pragma unroll
            for (int j = 0; j < 8; ++j) sm2 += (v[j][0] + v[j][1]) + (v[j][2] + v[j][3]);
            const float mean2 = wave_sum(sm2, lane) * (1.0f / DM); float q2 = 0.f;
#pragma unroll
            for (int j = 0; j < 8; ++j) { v[j] = v[j] - mean2; q2 += (v[j][0] * v[j][0] + v[j][1] * v[j][1]) + (v[j][2] * v[j][2] + v[j][3] * v[j][3]); }
            const float rstd2 = 1.0f / sqrtf(wave_sum(q2, lane) * (1.0f / DM) + LN_EPS);
            u32x2* o = (u32x2*)(H + (size_t)row * DM) + lane;
#pragma unroll
            for (int j = 0; j < 8; ++j) { const f32x4 h = v[j] * rstd2 * sc[j] + sh[j]; u32x2 w; w.x = pk2(h[0], h[1]); w.y = pk2(h[2], h[3]); o[64 * j] = w; }
        }
    }
}

__device__ __forceinline__ void s5_scan_phase(Frame& F, int par) {
    const int gw = F.bid * 8 + F.wave, NGW = F.G * 8;
    const float* E = (const float*)(F.ws + WS_E); bf16_t* Xs = (bf16_t*)(F.ws + WS_XS); const float* AT = (const float*)(F.ws + WS_AT + (size_t)par * AT_STRIDE);
    for (int it = gw; it < NBATCH * 32 * 2; it += NGW) {
        const int b = it >> 6, g = (it >> 1) & 31, d = it & 1, p = F.lane;
        const float ar = AT[((g * 2 + d) * 64 + p) * 2], ai = AT[((g * 2 + d) * 64 + p) * 2 + 1];
        float hr = 0.f, hi = 0.f;
        for (int c0 = 0; c0 < 72; c0 += 8) {
            float er[8], ei[8]; int rows[8];
#pragma unroll
            for (int q = 0; q < 8; ++q) { const int c = c0 + q;
                int row; if (c < 8) row = 1024 + b * 8 + (d == 0 ? c : 7 - c); else row = b * 64 + (d == 0 ? (c - 8) : 63 - (c - 8));
                rows[q] = row; const float* e = E + ((size_t)g * XS_ROWS + row) * 256 + d * 128 + p; er[q] = e[0]; ei[q] = e[64]; }
#pragma unroll
            for (int q = 0; q < 8; ++q) {
                bf16_t* xs = Xs + ((size_t)g * XS_ROWS + rows[q]) * XS_K + 512 + d * 128 + p;
                xs[0] = (bf16_t)(pk2(hr, 0.f) & 0xffffu); xs[64] = (bf16_t)(pk2(hi, 0.f) & 0xffffu);
                const float nr = ar * hr - ai * hi + er[q], ni = ar * hi + ai * hr + ei[q]; hr = nr; hi = ni;
            }
        }
    }
}

__device__ __forceinline__ void sgu_phase(Frame& F, int l, int u_first, int u_end) {
    const bf16_t* vT = (const bf16_t*)(F.ws + WS_VTS); const bf16_t* Z = (const bf16_t*)(F.ws + WS_Z); bf16_t* Y = (bf16_t*)(F.ws + WS_Y);
    const bf16_t* wsb = (const bf16_t*)(F.ws + WS_WSGU + (size_t)(l & 1) * SMALL_STRIDE); const float* bsg = F.in[F.zi + I_BSGU] + (size_t)l * 4 * 128;
    LAS float* part = (LAS float*)(F.lds);
    LAS float* stat = (LAS float*)(F.lds + 8192);
    LAS unsigned char* tile = F.lds + 16384;
    const int lane = F.lane, w = F.wave, tid = F.tid;
    for (int uu = u_first; uu < u_end; uu += F.G) {
        const int ck = uu >> 2, g = uu & 3;
        const int tok0 = ck < 256 ? ck * 128 : MX + (ck - 256) * 128;
        u32x4 tv[4];
#pragma unroll
        for (int j = 0; j < 4; ++j) { const int e = tid + 512 * j, c = e >> 4, ch16 = e & 15; tv[j] = *(const u32x4*)(vT + (size_t)(g * 128 + c) * MT + tok0 + 8 * ch16); }
        {
          float sa[8], qa[8];
#pragma unroll
          for (int e = 0; e < 8; ++e) { sa[e] = 0.f; qa[e] = 0.f; }
          const bf16_t* src = vT + (size_t)(64 * w + (lane >> 4)) * MT + tok0 + 8 * (lane & 15);
#pragma unroll
          for (int i = 0; i < 16; ++i) { const u32x4 x = *(const u32x4*)(src + (size_t)(4 * i) * MT);
              const float f0 = bflo(x.x), f1 = bfhi(x.x), f2 = bflo(x.y), f3 = bfhi(x.y), f4 = bflo(x.z), f5 = bfhi(x.z), f6 = bflo(x.w), f7 = bfhi(x.w);
              sa[0] += f0; qa[0] += f0 * f0; sa[1] += f1; qa[1] += f1 * f1; sa[2] += f2; qa[2] += f2 * f2; sa[3] += f3; qa[3] += f3 * f3;
              sa[4] += f4; qa[4] += f4 * f4; sa[5] += f5; qa[5] += f5 * f5; sa[6] += f6; qa[6] += f6 * f6; sa[7] += f7; qa[7] += f7 * f7; }
#pragma unroll
          for (int e = 0; e < 8; ++e) { sa[e] += shx(sa[e], 16, lane); qa[e] += shx(qa[e], 16, lane); sa[e] += shx(sa[e], 32, lane); qa[e] += shx(qa[e], 32, lane); }
          if (lane < 16) {
#pragma unroll
              for (int e = 0; e < 8; ++e) { part[(w * 128 + 8 * lane + e) * 2] = sa[e]; part[(w * 128 + 8 * lane + e) * 2 + 1] = qa[e]; } } }
#pragma unroll
        for (int j = 0; j < 4; ++j) { const int e = tid + 512 * j, c = e >> 4, ch16 = e & 15; *(LAS u32x4*)(tile + c * 272 + ch16 * 16) = tv[j]; }
        __syncthreads();
        if (tid < 128) { float s = 0.f, q = 0.f;
#pragma unroll
            for (int ww = 0; ww < 8; ++ww) { s += part[(ww * 128 + tid) * 2]; q += part[(ww * 128 + tid) * 2 + 1]; }
            const float mean = s * (1.0f / 512.0f); float var = q * (1.0f / 512.0f) - mean * mean; var = var < 0.f ? 0.f : var;
            stat[tid * 2] = mean; stat[tid * 2 + 1] = 1.0f / sqrtf(var + LN_EPS); }
        __syncthreads();
        const int p = 16 * w + (lane & 15), kq = lane >> 4;
        {
            bf16x8 bfr[4]; float corr = 0.f;
            u32x4 wv4[4];
#pragma unroll
            for (int ks = 0; ks < 4; ++ks) wv4[ks] = *(const u32x4*)(wsb + ((size_t)g * 128 + p) * 128 + 32 * ks + 8 * kq);
            asm volatile("" ::: "memory");
#pragma unroll
            for (int ks = 0; ks < 4; ++ks) {
                const u32x4 wv = wv4[ks];
                const int q0 = 32 * ks + 8 * kq; float a[8];
                a[0] = bflo(wv.x); a[1] = bfhi(wv.x); a[2] = bflo(wv.y); a[3] = bfhi(wv.y); a[4] = bflo(wv.z); a[5] = bfhi(wv.z); a[6] = bflo(wv.w); a[7] = bfhi(wv.w);
                u32x4 o; unsigned pk[4];
#pragma unroll
                for (int j = 0; j < 4; ++j) { const float r0 = stat[(q0 + 2 * j) * 2 + 1], r1 = stat[(q0 + 2 * j + 1) * 2 + 1]; pk[j] = pk2(a[2 * j] * r0, a[2 * j + 1] * r1);
                    corr += bflo(pk[j]) * stat[(q0 + 2 * j) * 2] + bfhi(pk[j]) * stat[(q0 + 2 * j + 1) * 2]; }
                o.x = pk[0]; o.y = pk[1]; o.z = pk[2]; o.w = pk[3];
                bfr[ks] = __builtin_bit_cast(bf16x8, o);
            }
            corr += shx(corr, 16, lane); corr += shx(corr, 32, lane);
            const float addp = bsg[g * 128 + p] - corr;
            const size_t tok = (size_t)(tok0 + p);
            u32x2 ua[8], ga[8];
#pragma unroll
            for (int ct = 0; ct < 8; ++ct) { const int ch = g * 128 + ct * 16 + 4 * kq; ua[ct] = *(const u32x2*)(Z + tok * LDZ + ZC_AU + ch); ga[ct] = *(const u32x2*)(Z + tok * LDZ + ZC_GATE + ch); }
            f32x4 acc[8];
#pragma unroll
            for (int ct = 0; ct < 8; ++ct) {
                acc[ct] = (f32x4){0.f, 0.f, 0.f, 0.f};
#pragma unroll
                for (int ks = 0; ks < 4; ++ks) {
                    const bf16x8 af = *(const LAS bf16x8*)(tile + (ct * 16 + (lane & 15)) * 272 + (32 * ks + 8 * kq) * 2);
                    acc[ct] = __builtin_amdgcn_mfma_f32_16x16x32_bf16(af, bfr[ks], acc[ct], 0, 0, 0);
                }
            }
#pragma unroll
            for (int ct = 0; ct < 8; ++ct) {
                const int ch = g * 128 + ct * 16 + 4 * kq;
                const u32x2 uu2 = ua[ct], gg = ga[ct];
                u32x2 o;
                o.x = pk2((acc[ct][0] + addp) * bflo(uu2.x) * bflo(gg.x), (acc[ct][1] + addp) * bfhi(uu2.x) * bfhi(gg.x));
                o.y = pk2((acc[ct][2] + addp) * bflo(uu2.y) * bflo(gg.y), (acc[ct][3] + addp) * bfhi(uu2.y) * bfhi(gg.y));
                *(u32x2*)(Y + tok * DM + ch) = o;
            }
        }
        __syncthreads();
    }
}

constexpr int ATT_KROW = 272, ATT_VROW = 80, ATT_KBUF = 32 * ATT_KROW, ATT_VBUF = 128 * ATT_VROW;
constexpr int ATT_VOFF = 2 * ATT_KBUF, ATT_RPB = 38912;
__device__ __forceinline__ void att_block_unit(Frame& F, int u) {
    const bf16_t* Z = (const bf16_t*)(F.ws + WS_Z); const bf16_t* Vt = (const bf16_t*)(F.ws + WS_VT); bf16_t* Y = (bf16_t*)(F.ws + WS_Y);
    const LAS float* rpb_s = (const LAS float*)(F.lds + ATT_RPB);
    const int lane = F.lane, l31 = lane & 31, hh = lane >> 5, w = F.wave, tid = F.tid;
    const bool band = u < 512;
    int b, h, r0;
    if (band) { b = u >> 5; h = (u >> 3) & 3; r0 = (u & 7) * 4; } else { const int v = u - 512; b = v >> 2; h = v & 3; r0 = 0; }
    const int half = w & 1, r = r0 + (w >> 1);
    const int qtok0 = band ? b * SEQ + r * 64 + half * 32 : MX + b * CTXL + w * 32;
    const int rs = r < 4 ? 0 : (r > 28 ? 24 : r - 4);
    const int rlo = r0 < 4 ? 0 : (r0 > 28 ? 24 : r0 - 4);
    const int rhi = ((r0 + 3) < 4 ? 0 : ((r0 + 3) > 28 ? 24 : r0 + 3 - 4)) + 7;
    const int npair = (rhi - rlo + 2) >> 1;
    const int nsteps = band ? 8 + 4 * npair : 8;
    const int wq = half * 32 + l31;
    const int cst = wq < 8 ? 0 : (wq > 56 ? 48 : wq - 8);
    const unsigned long long wmask = 0xFFFFull << cst;
    const int ctxtok = MX + b * CTXL, xtok = b * SEQ;
    bf16x8 qf[8];
    { const bf16_t* qp = Z + (size_t)(qtok0 + l31) * LDZ + ZC_Q + h * 128 + 8 * hh;
#pragma unroll
      for (int s = 0; s < 8; ++s) qf[s] = *(const bf16x8*)(qp + 16 * s); }
    f32x16 O[4];
#pragma unroll
    for (int dt = 0; dt < 4; ++dt)
#pragma unroll
        for (int i = 0; i < 16; ++i) O[dt][i] = 0.f;
    float mrun = -3.0e38f, lrun = 0.f;
    const int kkey = tid >> 4, kch = tid & 15, vd = tid >> 2, vpc = tid & 3;
    const bf16_t* kgb = Z + ZC_K + h * 128 + 8 * kch;
    const bf16_t* vgb = Vt + (size_t)(h * 128 + vd) * MT;
    LAS unsigned char* kst = F.lds + kkey * ATT_KROW + kch * 16;
    LAS unsigned char* vst = F.lds + ATT_VOFF + vd * ATT_VROW + (vpc >> 1) * 32 + (vpc & 1) * 8;
    const LAS unsigned char* krd = F.lds + l31 * ATT_KROW + 16 * hh;
    const LAS unsigned char* vrd = F.lds + ATT_VOFF + l31 * ATT_VROW + 16 * hh;
    u32x4 kreg, vreg, kreg2, vreg2;
#define ATT_LOAD(t) do { int kt_, vt_; \
        if ((t) < 8) { kt_ = ctxtok + 32 * (t) + kkey; vt_ = ctxtok + 32 * (t) + 8 * vpc; } \
        else { const int tb_ = (t) - 8, R0_ = rlo + 2 * (tb_ >> 2), cb_ = tb_ & 3; kt_ = xtok + (R0_ + (kkey >> 4)) * 64 + 16 * cb_ + (kkey & 15); vt_ = xtok + (R0_ + (vpc >> 1)) * 64 + 16 * cb_ + 8 * (vpc & 1); } \
        kreg = *(const u32x4*)(kgb + (size_t)kt_ * LDZ); vreg = *(const u32x4*)(vgb + vt_); } while (0)
#define ATT_LOADR(t, KR, VR) do { int kt_, vt_; \
        if ((t) < 8) { kt_ = ctxtok + 32 * (t) + kkey; vt_ = ctxtok + 32 * (t) + 8 * vpc; } \
        else { const int tb_ = (t) - 8, R0_ = rlo + 2 * (tb_ >> 2), cb_ = tb_ & 3; kt_ = xtok + (R0_ + (kkey >> 4)) * 64 + 16 * cb_ + (kkey & 15); vt_ = xtok + (R0_ + (vpc >> 1)) * 64 + 16 * cb_ + 8 * (vpc & 1); } \
        KR = *(const u32x4*)(kgb + (size_t)kt_ * LDZ); VR = *(const u32x4*)(vgb + vt_); } while (0)
#define ATT_STORER(nx, KR, VR) do { *(LAS u32x4*)(kst + (nx) * ATT_KBUF) = KR; LAS u32x2* vs_ = (LAS u32x2*)(vst + (nx) * ATT_VBUF); vs_[0] = (u32x2){VR.x, VR.y}; vs_[2] = (u32x2){VR.z, VR.w}; } while (0)
    ATT_LOADR(0, kreg, vreg);
    ATT_STORER(0, kreg, vreg);
    ATT_LOADR(1, kreg2, vreg2);
    __syncthreads();
    for (int t0 = 0; t0 < nsteps; t0 += 2) {
        {
            const int t = t0;
            if (t + 2 < nsteps) ATT_LOADR(t + 2, kreg, vreg);
        const bool isb = t >= 8;
        const int tb = t - 8, R0 = rlo + 2 * (tb >> 2), cb = tb & 3;
        const bool part = !isb || ((cb >= half) && (cb <= half + 2) && (R0 + 1 >= rs) && (R0 <= rs + 7));
        if (part) {
            const LAS unsigned char* kb = krd + 0 * ATT_KBUF; const LAS unsigned char* vb = vrd + 0 * ATT_VBUF;
            f32x16 S, S2; bf16x8 kf[8];
#pragma unroll
            for (int i = 0; i < 16; ++i) { S[i] = 0.f; S2[i] = 0.f; }
#pragma unroll
            for (int s = 0; s < 8; ++s) kf[s] = *(const LAS bf16x8*)(kb + 32 * s);
#pragma unroll
            for (int s = 0; s < 8; s += 2) {
                S = __builtin_amdgcn_mfma_f32_32x32x16_bf16(kf[s], qf[s], S, 0, 0, 0);
                S2 = __builtin_amdgcn_mfma_f32_32x32x16_bf16(kf[s + 1], qf[s + 1], S2, 0, 0, 0); }
            bf16x8 vf[2][4];
#pragma unroll
            for (int s2 = 0; s2 < 2; ++s2)
#pragma unroll
                for (int dt = 0; dt < 4; ++dt) vf[s2][dt] = *(const LAS bf16x8*)(vb + (32 * dt) * ATT_VROW + 32 * s2);
#pragma unroll
            for (int i = 0; i < 16; ++i) S[i] += S2[i];
            if (isb) {
                const int sh = 16 * cb + 4 * hh;
                const unsigned ml = (unsigned)(wmask >> sh);
                const unsigned m0 = ((R0 >= rs) && (R0 <= rs + 7)) ? ml : 0u, m1 = ((R0 + 1 >= rs) && (R0 + 1 <= rs + 7)) ? ml : 0u;
                const LAS float* rp = rpb_s + h * 465 + (R0 - r + 7) * 31 + 15 + (sh - wq);
#pragma unroll
                for (int i = 0; i < 16; ++i) {
                    const int c = (i & 3) + 8 * ((i >> 2) & 1);
                    const unsigned mm = (i >> 3) ? m1 : m0;
                    const float rv = rp[(i >> 3) * 31 + c];
                    S[i] = ((mm >> c) & 1u) ? S[i] + rv : -1.0e30f;
                }
            }
            float tmax = S[0];
#pragma unroll
            for (int i = 1; i < 16; ++i) tmax = fmaxf(tmax, S[i]);
            tmax = fmaxf(tmax, shx(tmax, 32, lane));
            if (__any(tmax > mrun + 8.0f)) {
                const float mnew = fmaxf(mrun, tmax);
                const float alpha = __builtin_amdgcn_exp2f(mrun - mnew);
                lrun *= alpha; mrun = mnew;
#pragma unroll
                for (int dt = 0; dt < 4; ++dt)
#pragma unroll
                    for (int i = 0; i < 16; ++i) O[dt][i] *= alpha;
            }
            float ls = 0.f;
#pragma unroll
            for (int i = 0; i < 16; ++i) { S[i] = __builtin_amdgcn_exp2f(S[i] - mrun); ls += S[i]; }
            lrun += ls;
#pragma unroll
            for (int s2 = 0; s2 < 2; ++s2) {
                u32x4 pp; pp.x = pk2(S[8 * s2 + 0], S[8 * s2 + 1]); pp.y = pk2(S[8 * s2 + 2], S[8 * s2 + 3]); pp.z = pk2(S[8 * s2 + 4], S[8 * s2 + 5]); pp.w = pk2(S[8 * s2 + 6], S[8 * s2 + 7]);
                const bf16x8 pf = __builtin_bit_cast(bf16x8, pp);
#pragma unroll
                for (int dt = 0; dt < 4; ++dt) {
                    O[dt] = __builtin_amdgcn_mfma_f32_32x32x16_bf16(vf[s2][dt], pf, O[dt], 0, 0, 0);
                }
            }
        }
            ATT_STORER(1, kreg2, vreg2);
            __syncthreads();
        }
        {
            const int t = t0 + 1;
            if (t + 2 < nsteps) ATT_LOADR(t + 2, kreg2, vreg2);
        const bool isb = t >= 8;
        const int tb = t - 8, R0 = rlo + 2 * (tb >> 2), cb = tb & 3;
        const bool part = !isb || ((cb >= half) && (cb <= half + 2) && (R0 + 1 >= rs) && (R0 <= rs + 7));
        if (part) {
            const LAS unsigned char* kb = krd + 1 * ATT_KBUF; const LAS unsigned char* vb = vrd + 1 * ATT_VBUF;
            f32x16 S, S2; bf16x8 kf[8];
#pragma unroll
            for (int i = 0; i < 16; ++i) { S[i] = 0.f; S2[i] = 0.f; }
#pragma unroll
            for (int s = 0; s < 8; ++s) kf[s] = *(const LAS bf16x8*)(kb + 32 * s);
#pragma unroll
            for (int s = 0; s < 8; s += 2) {
                S = __builtin_amdgcn_mfma_f32_32x32x16_bf16(kf[s], qf[s], S, 0, 0, 0);
                S2 = __builtin_amdgcn_mfma_f32_32x32x16_bf16(kf[s + 1], qf[s + 1], S2, 0, 0, 0); }
            bf16x8 vf[2][4];
#pragma unroll
            for (int s2 = 0; s2 < 2; ++s2)
#pragma unroll
                for (int dt = 0; dt < 4; ++dt) vf[s2][dt] = *(const LAS bf16x8*)(vb + (32 * dt) * ATT_VROW + 32 * s2);
#pragma unroll
            for (int i = 0; i < 16; ++i) S[i] += S2[i];
            if (isb) {
                const int sh = 16 * cb + 4 * hh;
                const unsigned ml = (unsigned)(wmask >> sh);
                const unsigned m0 = ((R0 >= rs) && (R0 <= rs + 7)) ? ml : 0u, m1 = ((R0 + 1 >= rs) && (R0 + 1 <= rs + 7)) ? ml : 0u;
                const LAS float* rp = rpb_s + h * 465 + (R0 - r + 7) * 31 + 15 + (sh - wq);
#pragma unroll
                for (int i = 0; i < 16; ++i) {
                    const int c = (i & 3) + 8 * ((i >> 2) & 1);
                    const unsigned mm = (i >> 3) ? m1 : m0;
                    const float rv = rp[(i >> 3) * 31 + c];
                    S[i] = ((mm >> c) & 1u) ? S[i] + rv : -1.0e30f;
                }
            }
            float tmax = S[0];
#pragma unroll
            for (int i = 1; i < 16; ++i) tmax = fmaxf(tmax, S[i]);
            tmax = fmaxf(tmax, shx(tmax, 32, lane));
            if (__any(tmax > mrun + 8.0f)) {
                const float mnew = fmaxf(mrun, tmax);
                const float alpha = __builtin_amdgcn_exp2f(mrun - mnew);
                lrun *= alpha; mrun = mnew;
#pragma unroll
                for (int dt = 0; dt < 4; ++dt)
#pragma unroll
                    for (int i = 0; i < 16; ++i) O[dt][i] *= alpha;
            }
            float ls = 0.f;
#pragma unroll
            for (int i = 0; i < 16; ++i) { S[i] = __builtin_amdgcn_exp2f(S[i] - mrun); ls += S[i]; }
            lrun += ls;
#pragma unroll
            for (int s2 = 0; s2 < 2; ++s2) {
                u32x4 pp; pp.x = pk2(S[8 * s2 + 0], S[8 * s2 + 1]); pp.y = pk2(S[8 * s2 + 2], S[8 * s2 + 3]); pp.z = pk2(S[8 * s2 + 4], S[8 * s2 + 5]); pp.w = pk2(S[8 * s2 + 6], S[8 * s2 + 7]);
                const bf16x8 pf = __builtin_bit_cast(bf16x8, pp);
#pragma unroll
                for (int dt = 0; dt < 4; ++dt) {
                    O[dt] = __builtin_amdgcn_mfma_f32_32x32x16_bf16(vf[s2][dt], pf, O[dt], 0, 0, 0);
                }
            }
        }
            if (t + 1 < nsteps) ATT_STORER(0, kreg, vreg);
            __syncthreads();
        }
    }
#undef ATT_LOADR
#undef ATT_STORER
#undef ATT_LOAD
    const size_t qtok = (size_t)(qtok0 + l31);
    u32x2 gq[4][4];
#pragma unroll
    for (int dt = 0; dt < 4; ++dt)
#pragma unroll
        for (int qd = 0; qd < 4; ++qd) gq[dt][qd] = *(const u32x2*)(Z + qtok * LDZ + ZC_GATE + 1024 + h * 128 + 32 * dt + 8 * qd + 4 * hh);
    const float ltot = lrun + shx(lrun, 32, lane);
    const float inv = 1.0f / ltot;
#pragma unroll
    for (int dt = 0; dt < 4; ++dt)
#pragma unroll
        for (int qd = 0; qd < 4; ++qd) {
            const int d0 = h * 128 + 32 * dt + 8 * qd + 4 * hh;
            const u32x2 gg = gq[dt][qd];
            u32x2 o;
            o.x = pk2(O[dt][4 * qd + 0] * inv * bflo(gg.x), O[dt][4 * qd + 1] * inv * bfhi(gg.x));
            o.y = pk2(O[dt][4 * qd + 2] * inv * bflo(gg.y), O[dt][4 * qd + 3] * inv * bfhi(gg.y));
            *(u32x2*)(Y + qtok * DM + 1024 + d0) = o;
        }
}
__device__ __forceinline__ void att_phase(Frame& F, int l, int nunits) {
    LAS float* rpb_s = (LAS float*)(F.lds + ATT_RPB);
    const float* rpb = F.in[F.zi + I_RPB] + (size_t)l * 4 * 465;
    __syncthreads();
    { float rv[4];
#pragma unroll
      for (int i = 0; i < 4; ++i) { const int e = F.tid + 512 * i; rv[i] = rpb[e < 4 * 465 ? e : 4 * 465 - 1]; }
#pragma unroll
      for (int i = 0; i < 4; ++i) { const int e = F.tid + 512 * i; if (e < 4 * 465) rpb_s[e] = rv[i] * 1.4426950408889634f; } }
    __syncthreads();
    for (int u = (F.bid + F.G - 64) % F.G; u < nunits; u += F.G) att_block_unit(F, u);
    __syncthreads();
}

constexpr int NPH_LAYER = 9, NPH = 2 + DEPTH * NPH_LAYER;
__global__ void __launch_bounds__(512, 2) fwd_kernel(Args args) {
    extern __shared__ __attribute__((aligned(16))) unsigned char lds[];
    Frame F;
    F.lds = (LAS unsigned char*)lds; F.tid = threadIdx.x; F.lane = F.tid & 63; F.wave = __builtin_amdgcn_readfirstlane(F.tid >> 6); F.wave0 = F.wave; F.G = gridDim.x; F.bid = blockIdx.x; F.G0 = F.G; F.bid0 = F.bid;
    F.ws = args.ws; F.ws0 = args.ws; F.in = args.in; F.zi = 0; F.out = args.out; F.out0 = args.out;
    volatile LAS unsigned* MISC = (volatile LAS unsigned*)(F.lds + MISC_OFF);
    if (F.tid < 64) MISC[F.tid] = 0u;
    __syncthreads();
    unsigned* ctl = (unsigned*)(F.ws + WS_CTL);
    XcdBarrier bar; bar.bar = ctl + 4096; bar.x = 0; bar.st = nullptr;
    if (!MK_MULTI) bar = xcd_barrier_post(ctl + 4096, MISC + 8, F.tid);
    const int lo = MK_MULTI ? args.p_lo : 0, hi = MK_MULTI ? args.p_hi : NPH;
#ifndef PHMASK
#define PHMASK 0xFFFFFFFFu
#endif
#define PH(k) ((PHMASK >> (k)) & 1u)
#ifndef REPMASK
#define REPMASK 0u
#endif
#define REP(k) for (int rep_ = 0; rep_ < (((REPMASK >> (k)) & 1u) ? 2 : 1); ++rep_)
#define IN(k) (lo <= (k) && (k) < hi)
#define SEAM(k) do { if (IN(k) && IN((k) + 1)) xcd_barrier(bar, F.wave0); } while (0)
    LAS unsigned char* ring = F.lds;
#define Zb ((bf16_t*)(F.ws + WS_Z))
#define Hb ((bf16_t*)(F.ws + WS_H))
#define Yb ((bf16_t*)(F.ws + WS_Y))
#define Xs ((bf16_t*)(F.ws + WS_XS))
#define ctxr ((float*)(F.ws + WS_CTXR))
#define ada_all ((const float*)(F.ws + WS_ADA))

    if (PH(0) && IN(0)) REP(0) { refresh(F); prologue_a(F); setup_layer(F, 0, 0, F.G); }
    SEAM(0);
    if (PH(1) && IN(1)) { refresh(F); ada_reduce(F); }
    SEAM(1);
    for (int l = 0; l < DEPTH; ++l) {
        const int base = 2 + l * NPH_LAYER;
        const int par = l & 1;
        const bool lastl = (l == DEPTH - 1); const int mrows = lastl ? MX / 256 : MT / 256;
#define ada_l (ada_all + (size_t)l * 17 * 6144)
        if (l == 0) {
            if (PH(2) && IN(base + 0)) REP(2) { refresh(F); ln_phase(F, 0, F.in[F.zi + I_X], F.in[F.zi + I_CTX], nullptr, nullptr, nullptr, nullptr, ada_l, MT); }
            SEAM(base + 0);
        }
        if (PH(3) && IN(base + 1)) REP(3) { refresh(F);
            { const bf16_t* Wi = (const bf16_t*)(F.ws + (par ? WS_WIN2 : WS_WIN)); const bf16_t* Ws = (const bf16_t*)(F.ws + (par ? WS_WSW2 : WS_WSW));
              pg8::Gemm g{Hb, Wi, DM, DM, DM, (size_t)((const char*)Ws - (const char*)Hb), (size_t)((const char*)Hb - (const char*)Wi)};
              pg8::G1Order S; S.G = F.G; S.c = F.bid; S.lastl = lastl;
              Epi1ab E{Epi1a{Zb, Xs, (const float*)(F.ws + WS_BIAS1A + (size_t)par * SMALL_STRIDE), (bf16_t*)(F.ws + WS_ZM)}, Epi1b{(bf16_t*)(F.ws + WS_VT), (bf16_t*)(F.ws + WS_VTS), (const float*)(F.ws + WS_BIAS1B + (size_t)par * SMALL_STRIDE)}, F.lds, 0};
              pg8::gemm_phase<Epi1ab, pg8::G1Order>(ring, g, S, E, F.tid); }
            if (l + 1 < DEPTH && F.bid >= 96) setup_layer(F, l + 1, 96, 160);
        }
        SEAM(base + 1);
        if (PH(4) && IN(base + 2)) REP(4) { refresh(F);
            { pg8::Gemm g{(const bf16_t*)(F.ws + (par ? WS_WFT2 : WS_WFT)), Zb + ZC_B, 512, LDZ, 512, 0, 0}; pg8::StaticOrder S; S.init(4, mrows, F.G, F.bid);
              EpiB1 E{(bf16_t*)(F.ws + WS_PTX), (bf16_t*)(F.ws + WS_PTC)};
              pg8::gemm_phase<EpiB1, pg8::StaticOrder>(ring, g, S, E, F.tid); }
            { pg8::Gemm g{Xs, (const bf16_t*)(F.ws + (par ? WS_MEND2 : WS_MEND)), XS_K, 512, 512, (size_t)XS_ROWS * XS_K * 2, (size_t)256 * 512 * 2}; pg8::BatchOrder S; S.init(5, 1, 32, F.G, (F.bid + F.G - 64) % F.G);
              EpiS5E E{(float*)(F.ws + WS_E)};
              pg8::gemm_phase<EpiS5E, pg8::BatchOrder>(ring, g, S, E, F.tid); }
            sgu_phase(F, l, (F.bid + F.G - 96) % F.G, lastl ? 1024 : 736);
            att_phase(F, l, lastl ? 512 : 576);
        }
        SEAM(base + 2);
        if (PH(5) && IN(base + 3)) REP(5) { refresh(F);
            { pg8::Gemm g{(const bf16_t*)(F.ws + WS_DFT), (const bf16_t*)(F.ws + WS_PTX), 4096, 4096, 4096, 0, 0}; pg8::StaticOrder S; S.init(8, 32, F.G, F.bid);
              EpiFB2<false> E{Yb, Zb, F.in[F.zi + I_BFNET] + (size_t)l * 512};
              pg8::gemm_phase<EpiFB2<false>, pg8::StaticOrder>(ring, g, S, E, F.tid); }
            if (!lastl) { pg8::Gemm g{(const bf16_t*)(F.ws + WS_DFT256), (const bf16_t*)(F.ws + WS_PTC), 512, 512, 512, 0, 0}; pg8::StaticOrder S; S.init(1, 32, F.G, (F.bid + 32) % F.G);
              EpiFB2<true> E{Yb, Zb, F.in[F.zi + I_BFNET] + (size_t)l * 512};
              pg8::gemm_phase<EpiFB2<true>, pg8::StaticOrder>(ring, g, S, E, F.tid); }
            s5_scan_phase(F, par);
        }
        SEAM(base + 3);
        if (PH(6) && IN(base + 4)) REP(6) { refresh(F);
            pg8::Gemm g{Xs, (const bf16_t*)(F.ws + WS_W3 + (size_t)par * W3_STRIDE), XS_K, XS_K, XS_K, (size_t)XS_ROWS * XS_K * 2, (size_t)512 * 768 * 2}; pg8::BatchOrder S; S.init(lastl ? 4 : 5, 2, 32, F.G, F.bid);
            EpiS5Y E{(bf16_t*)(F.ws + WS_YD)};
            pg8::gemm_phase<EpiS5Y, pg8::BatchOrder>(ring, g, S, E, F.tid);
            if (!lastl && F.bid >= 64) sgu_phase(F, l, 736 + F.bid - 64, 928);
        }
        SEAM(base + 4);
        if (PH(7) && IN(base + 5)) REP(7) { refresh(F);
            pg8::Gemm g{(const bf16_t*)(F.ws + WS_YD), (const bf16_t*)(F.ws + WS_WGLU + (size_t)par * WGLU_STRIDE), 512, 512, 512, 0, 0}; pg8::StaticOrder S; S.init(mrows, 2, F.G, F.bid);
            EpiGLU E{Yb, (const bf16_t*)(F.ws + WS_YD), Zb, F.in[F.zi + I_BGLU] + (size_t)l * 512};
            pg8::gemm_phase<EpiGLU, pg8::StaticOrder>(ring, g, S, E, F.tid);
            if (!lastl && F.bid >= 32) sgu_phase(F, l, 928 + F.bid - 32, 1152);
        }
        SEAM(base + 5);
        if (PH(8) && IN(base + 6)) REP(8) { refresh(F);
            pg8::Gemm g{Yb, (const bf16_t*)(F.ws + WS_WUP + (size_t)par * WUP_STRIDE), DM, 512, 512, (size_t)512 * 2, (size_t)DM * 512 * 2}; pg8::QuadOrder S; S.init(2 * mrows, DM / 256, F.G, F.bid);
            EpiUP E; E.Mo = Hb; E.Z = (const bf16_t*)(F.ws + WS_ZM);
#pragma unroll
            for (int a = 0; a < 2; ++a)
#pragma unroll
                for (int m = 0; m < 4; ++m) { E.ms[a][m][0] = (f32x4){0.f, 0.f, 0.f, 0.f}; E.ms[a][m][1] = (f32x4){0.f, 0.f, 0.f, 0.f}; E.sg0[m & 1] = (u32x4){0u, 0u, 0u, 0u}; }
            pg8::gemm_phase_m128<EpiUP, pg8::QuadOrder>(ring, g, S, E, F.tid);
        }
        SEAM(base + 6);
        if (PH(9) && IN(base + 7)) REP(9) { refresh(F);
            pg8::Gemm g{Hb, (const bf16_t*)(F.ws + WS_WO + (size_t)par * WO_STRIDE), DM, DM, DM, 0, 0};
            EpiOUT E{l == 0 ? F.in[F.zi + I_X] : F.out, l == 0 ? F.in[F.zi + I_CTX] : ctxr, F.out, ctxr, ada_l,
                     (const float*)pg8::uni((const char*)(F.in[F.zi + I_LNG] + (size_t)(l > 0 ? l - 1 : 0) * DM)), (const float*)pg8::uni((const char*)(F.in[F.zi + I_LNB] + (size_t)(l > 0 ? l - 1 : 0) * DM)), (const float*)(F.ws + WS_RS), l == 0, F.lds, 0};
            const int lim = (mrows * (DM / 256) / F.G) * F.G;
            { pg8::HeadOrder S; S.init(mrows, DM / 256, F.G, F.bid); S.lim = lim;
              pg8::gemm_phase<EpiOUT, pg8::HeadOrder>(ring, g, S, E, F.tid); }
            { pg8::TailOrder S; S.init(mrows, DM / 256, F.G, F.bid); S.lim = lim;
              EpiOUTh Eh{E};
              pg8::gemm_phase_n128<EpiOUTh, pg8::TailOrder>(ring, g, S, Eh, F.tid); }
        }
        SEAM(base + 7);
        if (PH(10) && IN(base + 8)) REP(10) { refresh(F); ln2_phase(F, F.out, ctxr, F.in[F.zi + I_LNG] + (size_t)l * DM, F.in[F.zi + I_LNB] + (size_t)l * DM, l + 1 < DEPTH ? ada_all + (size_t)(l + 1) * 17 * 6144 : nullptr, lastl ? MX : MT); }
        if (l + 1 < DEPTH) { if (IN(base + 8) && IN(base + 8 + 2)) xcd_barrier(bar, F.wave0); }
    }
#undef IN
#undef SEAM
#undef Zb
#undef Hb
#undef Yb
#undef Xs
#undef ctxr
#undef ada_all
#undef ada_l
}

extern "C" void kernel_launch(void* const* d_in, const int* in_sizes, int n_in, void* d_out, int out_size, void* d_ws, size_t ws_size, hipStream_t stream) {
    static int grid = 0;
    if (grid == 0) {
        if (n_in != 27 || out_size != MX * DM || ws_size < WS_END) { fprintf(stderr, "kernel_launch: unexpected problem (n_in %d, out %d, ws %zu < %zu)\n", n_in, out_size, ws_size, (size_t)WS_END); grid = -1; return; }
        int dev = 0, cus = 0, per_cu = 0;
        if (hipGetDevice(&dev) != hipSuccess || hipDeviceGetAttribute(&cus, hipDeviceAttributeMultiprocessorCount, dev) != hipSuccess) { grid = -1; return; }
        if (hipFuncSetAttribute((const void*)fwd_kernel, hipFuncAttributeMaxDynamicSharedMemorySize, LDS_BYTES) != hipSuccess) { fprintf(stderr, "kernel_launch: hipFuncSetAttribute failed\n"); grid = -1; return; }
        if (hipOccupancyMaxActiveBlocksPerMultiprocessor(&per_cu, (const void*)fwd_kernel, 512, LDS_BYTES) != hipSuccess || per_cu < 1) { fprintf(stderr, "kernel_launch: occupancy query says %d\n", per_cu); }
        (void)hipGetLastError();
        grid = cus;
        if (grid != 256) fprintf(stderr, "kernel_launch: %d CUs (built for 256)\n", grid);
    }
    if (grid < 0) return;
    (void)hipMemsetAsync((char*)d_ws + WS_CTL, 0, CTL_ZERO_BYTES, stream);
    Args a{};
    for (int i = 0; i < 27; ++i) a.in[i] = (const float*)d_in[i];
    a.out = (float*)d_out; a.ws = (unsigned char*)d_ws;
#if MK_MULTI
    for (int p = 0; p < NPH; ++p) { if (p >= 2 + NPH_LAYER && (p - 2) % NPH_LAYER == 0) continue; a.p_lo = p; a.p_hi = p + 1; hipLaunchKernelGGL(fwd_kernel, dim3(grid), dim3(512), LDS_BYTES, stream, a); }
#else
    a.p_lo = 0; a.p_hi = NPH;
    hipLaunchKernelGGL(fwd_kernel, dim3(grid), dim3(512), LDS_BYTES, stream, a);
#endif
}
```
